# Optimizing an MI355X kernel written in HIP

```python
import jax, jax.numpy as jnp
from jax import lax
import numpy as np

D_MODEL = 1024
BATCH = 2
SEQ = 8192
DEPTH = 2

HEAD_DIM = 128
HEADS_PER_GROUP = 4
DILATION_GROUPS = ((128, 1), (512, 4), (2048, 16))
N_GROUPS = 3
ATT_WIDTH = HEADS_PER_GROUP * HEAD_DIM
QKV_WIDTH = N_GROUPS * ATT_WIDTH
BAND_BLOCK = 128
LRU_WIDTH = D_MODEL
LRU_BLOCKS = 16
LRU_BLOCK_DIM = LRU_WIDTH // LRU_BLOCKS
CONV_WIDTH = 4
LRU_C = 8.0
N_BRANCHES = 2
NORM_EPS = 1e-6
NEG_INF = -1e30
SPLIT_SIZES = (QKV_WIDTH, QKV_WIDTH, QKV_WIDTH, ATT_WIDTH, LRU_WIDTH, LRU_WIDTH, N_BRANCHES * D_MODEL)
IN_WIDTH = 3 * QKV_WIDTH + ATT_WIDTH + 2 * LRU_WIDTH + N_BRANCHES * D_MODEL

kernel_name = "hybrid_dilated_attn_rglru_block"


def rms_norm(x, gain):
    xf = x.astype(jnp.float32)
    y = xf * lax.rsqrt(jnp.mean(xf * xf, axis=-1, keepdims=True) + NORM_EPS)
    return (y * gain.astype(jnp.float32)).astype(x.dtype)


def dilated_window_group(q, k, v, window, dilation):
    B, S, H, Dh = q.shape
    span = window // dilation
    L = S // dilation
    n_blk = -(-L // BAND_BLOCK)
    Lp = n_blk * BAND_BLOCK

    def to_sub(t):
        t = t.astype(jnp.float32).reshape(B, L, dilation, H, Dh).transpose(0, 2, 1, 3, 4)
        return jnp.pad(t, ((0, 0), (0, 0), (0, Lp - L), (0, 0), (0, 0)))

    def band(t):
        t = jnp.pad(to_sub(t), ((0, 0), (0, 0), (BAND_BLOCK, 0), (0, 0), (0, 0)))
        t = t.reshape(B, dilation, n_blk + 1, BAND_BLOCK, H, Dh)
        return jnp.concatenate([t[:, :, :-1], t[:, :, 1:]], axis=3)

    qs = to_sub(q).reshape(B, dilation, n_blk, BAND_BLOCK, H, Dh)
    kb = band(k)
    vb = band(v)
    s = jnp.einsum('brnqhd,brnkhd->brnhqk', qs, kb) * (Dh ** -0.5)
    qi = jnp.arange(BAND_BLOCK)[:, None] + BAND_BLOCK
    ki = jnp.arange(2 * BAND_BLOCK)[None, :]
    dist = qi - ki
    key_pos = jnp.arange(n_blk)[:, None, None] * BAND_BLOCK + ki[None] - BAND_BLOCK
    valid = (dist >= 0) & (dist <= span) & (key_pos >= 0)
    s = jnp.where(valid[None, None, :, None], s, NEG_INF)
    m = jnp.max(s, axis=-1)
    p = jnp.exp(s - m[..., None])
    l = jnp.sum(p, axis=-1)
    m = jnp.swapaxes(m, -1, -2)
    l = jnp.swapaxes(l, -1, -2)
    o = jnp.einsum('brnhqk,brnkhd->brnqhd', p, vb) / l[..., None]

    def from_sub(t):
        t = t.reshape((B, dilation, Lp) + t.shape[4:])[:, :, :L]
        t = jnp.swapaxes(t, 1, 2)
        return t.reshape((B, S) + t.shape[3:])

    return from_sub(o), from_sub(m), from_sub(l)


def dilated_attention(q, k, v):
    B, S, _ = q.shape
    shp = (B, S, N_GROUPS, HEADS_PER_GROUP, HEAD_DIM)
    qg, kg, vg = q.reshape(shp), k.reshape(shp), v.reshape(shp)
    outs, maxes, dens = [], [], []
    for g, (window, dilation) in enumerate(DILATION_GROUPS):
        o, m, l = dilated_window_group(qg[:, :, g], kg[:, :, g], vg[:, :, g], window, dilation)
        outs.append(o)
        maxes.append(m)
        dens.append(l)
    o = jnp.stack(outs, 0)
    m = jnp.stack(maxes, 0)
    l = jnp.stack(dens, 0)
    wgt = l * jnp.exp(m - jnp.max(m, axis=0, keepdims=True))
    o = jnp.sum(wgt[..., None] * o, axis=0) / jnp.sum(wgt, axis=0)[..., None]
    return o.reshape(B, S, ATT_WIDTH).astype(q.dtype)


def causal_depthwise_conv(u, w, b):
    S = u.shape[1]
    up = jnp.pad(u, ((0, 0), (CONV_WIDTH - 1, 0), (0, 0)))
    y = b
    for j in range(CONV_WIDTH):
        y = y + up[:, CONV_WIDTH - 1 - j: CONV_WIDTH - 1 - j + S] * w[j]
    return y


def rg_lru(u, w_rg, b_rg, w_ig, b_ig, lru_lambda):
    B, S, _ = u.shape
    uf = u.astype(jnp.float32)
    ub = uf.reshape(B, S, LRU_BLOCKS, LRU_BLOCK_DIM)
    r = jax.nn.sigmoid(jnp.einsum('bshi,hij->bshj', ub, w_rg.astype(jnp.float32)).reshape(B, S, LRU_WIDTH) + b_rg.astype(jnp.float32))
    i = jax.nn.sigmoid(jnp.einsum('bshi,hij->bshj', ub, w_ig.astype(jnp.float32)).reshape(B, S, LRU_WIDTH) + b_ig.astype(jnp.float32))
    log_a = -LRU_C * r * jax.nn.softplus(-lru_lambda.astype(jnp.float32))
    a = jnp.exp(log_a)
    xin = jnp.sqrt(-jnp.expm1(2.0 * log_a)) * (i * uf)

    def combine(left, right):
        a1, b1 = left
        a2, b2 = right
        return a1 * a2, a2 * b1 + b2

    _, h = lax.associative_scan(combine, (a, xin), axis=1)
    return h.astype(u.dtype)


def hybrid_layer(x, c, w_mod, b_mod, g_pre, w_in, conv_w, conv_b, w_rg, b_rg, w_ig, b_ig,
                 lru_lambda, w_pa, w_pb, w_o, g_post):
    mod = jax.nn.silu(c) @ w_mod + b_mod
    shift, scale, gate = jnp.split(mod[:, None, :], 3, axis=-1)
    h = rms_norm(x, g_pre) * (1 + scale) + shift
    proj = h @ w_in
    split_at = [int(v) for v in np.cumsum(SPLIT_SIZES)[:-1]]
    q, k, v, g_att, u, g_lru, merge = jnp.split(proj, split_at, axis=-1)
    y_a = (dilated_attention(q, k, v) * jax.nn.silu(g_att)) @ w_pa
    u = causal_depthwise_conv(u, conv_w, conv_b)
    y_b = (rg_lru(u, w_rg, b_rg, w_ig, b_ig, lru_lambda) * jax.nn.silu(g_lru)) @ w_pb
    gate_a, gate_b = jnp.split(jax.nn.sigmoid(merge), N_BRANCHES, axis=-1)
    out = (gate_a * y_a + gate_b * y_b) @ w_o
    return x + gate * rms_norm(out, g_post)


def setup_inputs(seed: int = 0) -> dict:
    key = jax.random.key(seed)
    ks = jax.random.split(key, 20)
    f32 = jnp.float32
    nrm = lambda k, shape, s: jax.random.normal(k, shape, f32) * s
    u = jax.random.uniform(ks[13], (DEPTH, LRU_WIDTH), f32, 0.9, 0.999)
    a_base = u ** (1.0 / LRU_C)
    lru_lambda = jnp.log(a_base) - jnp.log1p(-a_base)
    return {
        "x": nrm(ks[0], (BATCH, SEQ, D_MODEL), 1.0),
        "c": nrm(ks[1], (BATCH, D_MODEL), 1.0),
        "w_mod": nrm(ks[2], (DEPTH, D_MODEL, 3 * D_MODEL), 0.5 * D_MODEL ** -0.5),
        "b_mod": nrm(ks[3], (DEPTH, 3 * D_MODEL), 0.01),
        "g_pre": 1.0 + nrm(ks[4], (DEPTH, D_MODEL), 0.05),
        "w_in": nrm(ks[5], (DEPTH, D_MODEL, IN_WIDTH), D_MODEL ** -0.5),
        "conv_w": nrm(ks[6], (DEPTH, CONV_WIDTH, LRU_WIDTH), CONV_WIDTH ** -0.5),
        "conv_b": nrm(ks[7], (DEPTH, LRU_WIDTH), 0.01),
        "w_rg": nrm(ks[8], (DEPTH, LRU_BLOCKS, LRU_BLOCK_DIM, LRU_BLOCK_DIM), LRU_BLOCK_DIM ** -0.5),
        "b_rg": nrm(ks[9], (DEPTH, LRU_WIDTH), 0.01),
        "w_ig": nrm(ks[10], (DEPTH, LRU_BLOCKS, LRU_BLOCK_DIM, LRU_BLOCK_DIM), LRU_BLOCK_DIM ** -0.5),
        "b_ig": nrm(ks[11], (DEPTH, LRU_WIDTH), 0.01),
        "lru_lambda": lru_lambda,
        "w_pa": nrm(ks[14], (DEPTH, ATT_WIDTH, D_MODEL), ATT_WIDTH ** -0.5),
        "w_pb": nrm(ks[15], (DEPTH, LRU_WIDTH, D_MODEL), LRU_WIDTH ** -0.5),
        "w_o": nrm(ks[16], (DEPTH, D_MODEL, D_MODEL), D_MODEL ** -0.5),
        "g_post": 1.0 + nrm(ks[17], (DEPTH, D_MODEL), 0.05),
    }


def reference(x, c, w_mod, b_mod, g_pre, w_in, conv_w, conv_b, w_rg, b_rg, w_ig, b_ig,
              lru_lambda, w_pa, w_pb, w_o, g_post):
    for layer in range(DEPTH):
        x = hybrid_layer(x, c, w_mod[layer], b_mod[layer], g_pre[layer], w_in[layer],
                         conv_w[layer], conv_b[layer], w_rg[layer], b_rg[layer],
                         w_ig[layer], b_ig[layer], lru_lambda[layer], w_pa[layer],
                         w_pb[layer], w_o[layer], g_post[layer])
    return x
```

```cpp
#include <hip/hip_runtime.h>
#include <hip/hip_cooperative_groups.h>
#include <cstdio>
namespace cg = cooperative_groups;
__device__ __forceinline__ int TIDX() { int v = threadIdx.x; asm volatile("" : "+v"(v)); return v; }
__device__ __forceinline__ int BIDX() { int v = blockIdx.x; asm volatile("" : "+s"(v)); return v; }
namespace pg8 {
#define PG8_LAS __attribute__((address_space(3)))
typedef unsigned short bf16_t;
typedef short bf16x8 __attribute__((ext_vector_type(8)));
typedef float f32x4 __attribute__((ext_vector_type(4)));
typedef unsigned u32x4 __attribute__((ext_vector_type(4)));
constexpr int BM = 256, BK = 64, HALF = 128, HTB = HALF * BK * 2  , STAGE_BYTES = 8 * HTB, NXCD = 8, WGM = 8;

__host__ __device__ __forceinline__ int lds_byte(int r, int c) { const int st = (r >> 4) * 2 + (c >> 5), rr = r & 15, cc = c & 31, ob = rr * 64 + cc * 2; return st * 1024 + (ob ^ (((ob >> 9) & 1) << 5)); }
__host__ __device__ __forceinline__ void stage_rc(int b, int& R, int& C) { const int st = b / 1024, sb = b % 1024, swz = sb ^ (((sb >> 9) & 1) << 5); R = (st >> 1) * 16 + swz / 64; C = (st & 1) * 32 + (swz % 64) / 2; }
__host__ __device__ __forceinline__ int perm32(int rho) { const int n = rho >> 4, i = rho & 15; return 8 * (i >> 2) + 4 * n + (i & 3); }

struct Unit { int pm, pn; };
struct Gemm { const bf16_t* A; const bf16_t* Bt; int M, N, K; };

struct StaticOrder {
    int nM, nN, nwg, G, c;
    __host__ __device__ void init(int M, int N, int G_, int c_) { nM = M / BM; nN = N / BM; nwg = nM * nN; G = G_; c = c_; }
    __host__ __device__ bool next(int i, Unit& u) const {
        const long L = (long)i * G + c; if (L >= nwg) return false;
        int wgid = (int)L; { const int q = nwg / NXCD, r = nwg % NXCD, xcd = wgid % NXCD, off = wgid / NXCD; wgid = (xcd < r ? xcd * (q + 1) : r * (q + 1) + (xcd - r) * q) + off; }
        const int nig = WGM * nN, gid = wgid / nig, fm = gid * WGM, gsz = (nM - fm) < WGM ? (nM - fm) : WGM;
        u.pm = fm + ((wgid % nig) % gsz); u.pn = (wgid % nig) / gsz; return true;
    }
    __device__ __forceinline__ void a_ready(const Unit&) const {}
    __device__ __forceinline__ void done(const Unit&) const {}
};
__device__ __forceinline__ unsigned cvt_pk_bf16(float lo, float hi) { unsigned r; asm volatile("v_cvt_pk_bf16_f32 %0, %1, %2" : "=v"(r) : "v"(lo), "v"(hi)); return r; }
template <class Epi, class Sched, bool STAMP = false>
__device__ __forceinline__ void gemm_phase(PG8_LAS unsigned char* lds, const Gemm g, const Sched& S, const Epi& E, unsigned long long* stamps) {
    const int tid = TIDX(), wid = __builtin_amdgcn_readfirstlane(tid >> 6), lane = tid & 63, wr = wid >> 2, wc = wid & 3, fr = lane & 15, fq = lane >> 4;
    const int K = g.K, nt = K / BK;
    int ts_lo = 0, ts_hi = 0, nts = 0; const unsigned long long rt_entry = STAMP ? (unsigned long long)wall_clock64() : 0ull;
#define PG8_STAMP() do { if (STAMP && wid == 0 && nts < 64) { const unsigned long long _c = (unsigned long long)clock64(); \
        ts_lo = (lane == nts) ? (int)(unsigned)_c : ts_lo; ts_hi = (lane == nts) ? (int)(unsigned)(_c >> 32) : ts_hi; ++nts; } } while (0)
    PG8_STAMP();
    unsigned voffA[2], voffB[2];
#pragma unroll
    for (int i = 0; i < 2; ++i) { int R, C; stage_rc(tid * 16 + i * 8192, R, C); const int Rb = Epi::PERM ? ((R & ~31) + perm32(R & 31)) : R;
        voffA[i] = (unsigned)(R * K + C) * 2u; voffB[i] = (unsigned)(Rb * K + C) * 2u; }
    const size_t kstep = (size_t)(BK * 2);
    const size_t hstep = (size_t)HALF * K * 2;
    const size_t tstep = 2 * hstep;
    const unsigned ldsw = (unsigned)wid * 1024u;
    const int aoff = lds_byte(wr * 64 + fr, fq * 8), boff = lds_byte(wc * 32 + fr, fq * 8);
#define PG8_SA(b, h) (((b) * 2 + (h)) * HTB)
#define PG8_SB(b, h) ((4 + (b) * 2 + (h)) * HTB)
#define PG8_STAGE(bufoff, gbase, voff) do { _Pragma("unroll") for (int _i = 0; _i < 2; ++_i) \
        __builtin_amdgcn_global_load_lds((const unsigned*)((const char*)(gbase) + (voff)[_i]), (PG8_LAS unsigned*)(lds + (bufoff) + ldsw + _i * 8192), 16, 0, 0); } while (0)
#define PG8_LDA(dst, b, h) do { _Pragma("unroll") for (int m = 0; m < 4; ++m) _Pragma("unroll") for (int k = 0; k < 2; ++k) dst[m][k] = *(const PG8_LAS bf16x8*)(lds + PG8_SA(b, h) + aoff + m * 2048 + k * 1024); } while (0)
#define PG8_LDB(dst, b, h) do { _Pragma("unroll") for (int n = 0; n < 2; ++n) _Pragma("unroll") for (int k = 0; k < 2; ++k) dst[n][k] = *(const PG8_LAS bf16x8*)(lds + PG8_SB(b, h) + boff + n * 2048 + k * 1024); } while (0)
#define PG8_MMA(ai, bj, At, Bt) do { __builtin_amdgcn_s_setprio(1); _Pragma("unroll") for (int m = 0; m < 4; ++m) _Pragma("unroll") for (int n = 0; n < 2; ++n) _Pragma("unroll") for (int k = 0; k < 2; ++k) \
        acc[ai][bj][m][n] = __builtin_amdgcn_mfma_f32_16x16x32_bf16(Bt[n][k], At[m][k], acc[ai][bj][m][n], 0, 0, 0); __builtin_amdgcn_s_setprio(0); } while (0)
#define PG8_WAIT_V(n) asm volatile("s_waitcnt vmcnt(" #n ")" ::: "memory")
#define PG8_WAIT_L(n) asm volatile("s_waitcnt lgkmcnt(" #n ")" ::: "memory")
#define PG8_BAR __builtin_amdgcn_s_barrier()
#define PG8_SCHED __builtin_amdgcn_sched_barrier(0)
    Unit cur, nxt; int ui = 0;
    if (!S.next(0, cur)) return;
    f32x4 acc[2][2][4][2];
#pragma unroll
    for (int a = 0; a < 2; ++a)
#pragma unroll
        for (int b = 0; b < 2; ++b)
#pragma unroll
            for (int m = 0; m < 4; ++m)
#pragma unroll
                for (int n = 0; n < 2; ++n) acc[a][b][m][n] = (f32x4){0.f, 0.f, 0.f, 0.f};
    bf16x8 At[4][2], B0[2][2], B1[2][2];
    const char* cA = (const char*)g.A + (size_t)cur.pm * tstep; const char* cB = (const char*)g.Bt + (size_t)cur.pn * tstep;
    S.a_ready(cur);
    PG8_STAGE(PG8_SB(0, 0), cB, voffB); PG8_STAGE(PG8_SA(0, 0), cA, voffA); PG8_STAGE(PG8_SB(0, 1), cB + hstep, voffB); PG8_STAGE(PG8_SA(0, 1), cA + hstep, voffA);
    if (wr == 1) PG8_BAR;
    PG8_WAIT_V(4); PG8_BAR;
    PG8_STAGE(PG8_SB(1, 0), cB + kstep, voffB); PG8_STAGE(PG8_SA(1, 0), cA + kstep, voffA); PG8_STAGE(PG8_SB(1, 1), cB + hstep + kstep, voffB);
    PG8_WAIT_V(6); PG8_BAR;
    PG8_STAMP();
    for (;;) {
        const bool has_next = S.next(ui + 1, nxt);
        const char* nA = has_next ? (const char*)g.A + (size_t)nxt.pm * tstep : cA; const char* nB = has_next ? (const char*)g.Bt + (size_t)nxt.pn * tstep : cB;
        for (int t = 0; t < nt; t += 2) {
            const bool last = (t == nt - 2);
            const char* a1 = cA + (size_t)(t + 1) * kstep;
            const char* a2 = last ? nA : cA + (size_t)(t + 2) * kstep; const char* b2 = last ? nB : cB + (size_t)(t + 2) * kstep;
            const char* a3 = a2 + kstep; const char* b3 = b2 + kstep;
            if (last && has_next) S.a_ready(nxt);
            if constexpr (Epi::MID_T >= 0) { if (t == Epi::MID_T) { PG8_SCHED; E.mid(acc, cur, wr, wc, fr, fq); PG8_SCHED; } }
            PG8_LDB(B0, 0, 0); PG8_SCHED; PG8_LDA(At, 0, 0); PG8_STAGE(PG8_SA(1, 1), a1 + hstep, voffA);
            PG8_WAIT_L(8); PG8_BAR; PG8_WAIT_L(0); PG8_MMA(0, 0, At, B0); PG8_BAR; PG8_SCHED;
            PG8_LDB(B1, 0, 1); PG8_STAGE(PG8_SB(0, 0), b2, voffB);
            PG8_BAR; PG8_WAIT_L(0); PG8_MMA(0, 1, At, B1); PG8_BAR;
            PG8_LDA(At, 0, 1); PG8_STAGE(PG8_SA(0, 0), a2, voffA);
            PG8_BAR; PG8_WAIT_L(0); PG8_MMA(1, 0, At, B0); PG8_BAR; PG8_SCHED;
            PG8_STAGE(PG8_SB(0, 1), b2 + hstep, voffB);
            PG8_WAIT_V(6); PG8_BAR; PG8_MMA(1, 1, At, B1); PG8_BAR;
            PG8_LDB(B0, 1, 0); PG8_SCHED; PG8_LDA(At, 1, 0); PG8_STAGE(PG8_SA(0, 1), a2 + hstep, voffA);
            PG8_WAIT_L(8); PG8_BAR; PG8_WAIT_L(0); PG8_MMA(0, 0, At, B0); PG8_BAR; PG8_SCHED;
            PG8_LDB(B1, 1, 1); PG8_STAGE(PG8_SB(1, 0), b3, voffB);
            PG8_BAR; PG8_WAIT_L(0); PG8_MMA(0, 1, At, B1); PG8_BAR;
            PG8_LDA(At, 1, 1); PG8_STAGE(PG8_SA(1, 0), a3, voffA);
            PG8_BAR; PG8_WAIT_L(0); PG8_MMA(1, 0, At, B0); PG8_BAR; PG8_SCHED;
            PG8_STAGE(PG8_SB(1, 1), b3 + hstep, voffB);
            PG8_WAIT_V(6); PG8_BAR; PG8_MMA(1, 1, At, B1); PG8_BAR;
        }
        PG8_STAMP();
        if constexpr (!Epi::AFTER_DRAIN) { E(acc, cur, wr, wc, fr, fq); S.done(cur); }
        PG8_STAMP();
        if (!has_next) break;
#pragma unroll
        for (int a = 0; a < 2; ++a)
#pragma unroll
            for (int b = 0; b < 2; ++b)
#pragma unroll
                for (int m = 0; m < 4; ++m)
#pragma unroll
                    for (int n = 0; n < 2; ++n) acc[a][b][m][n] = (f32x4){0.f, 0.f, 0.f, 0.f};
        cur = nxt; cA = nA; cB = nB; ++ui;
    }
    PG8_WAIT_V(0);
    if (wr == 0) PG8_BAR;
    PG8_BAR;
    if constexpr (Epi::AFTER_DRAIN) { E.fused(acc, cur, wr, wc, fr, fq, lds, wid, lane); S.done(cur); }
    PG8_STAMP();
    if (STAMP && wid == 0) { stamps[lane] = lane < nts ? (((unsigned long long)(unsigned)ts_hi << 32) | (unsigned)ts_lo) : 0ull;
        if (lane == 62) stamps[62] = rt_entry; if (lane == 63) stamps[63] = (unsigned long long)wall_clock64(); }
#undef PG8_STAMP
#undef PG8_SA
#undef PG8_SB
#undef PG8_STAGE
#undef PG8_LDA
#undef PG8_LDB
#undef PG8_MMA
#undef PG8_WAIT_V
#undef PG8_WAIT_L
#undef PG8_BAR
#undef PG8_SCHED
}
}

using pg8::bf16_t; using pg8::bf16x8; using pg8::f32x4; using pg8::u32x4;
#define LAS __attribute__((address_space(3)))
typedef short v4i16_t __attribute__((ext_vector_type(4)));
typedef unsigned u32x2 __attribute__((ext_vector_type(2)));

constexpr int DM = 1024, SEQ = 8192, MTOK = 16384;
constexpr size_t MiB = 1048576;
constexpr size_t SM_LAYER = 5 * MiB + 256 * 1024;
constexpr size_t OFF_WCAT = 0, OFF_WO = 3 * MiB, OFF_WRG = 5 * MiB, OFF_WIG = 5 * MiB + 128 * 1024;
constexpr size_t WS_MOD = 2 * SM_LAYER;
constexpr size_t WS_AGG = WS_MOD + 65536;
constexpr size_t WS_WIN = 12 * MiB;
constexpr size_t WS_H = 30 * MiB;
constexpr size_t WS_R = 62 * MiB;
constexpr size_t WS_GATT = 206 * MiB;
constexpr size_t WS_ACAT = 222 * MiB;
constexpr size_t WS_ML = 270 * MiB;
constexpr size_t WS_END = WS_ML + 2 * MiB;
constexpr int LDS_BYTES = 147968;
constexpr int NPHASE = 20;

struct Params {
  const float *x, *c, *w_mod, *b_mod, *g_pre, *w_in, *conv_w, *conv_b, *w_rg, *b_rg, *w_ig, *b_ig, *lam, *w_pa, *w_pb, *w_o, *g_post;
  float* out; unsigned char* ws; int ph_lo, ph_hi;
};

__device__ __forceinline__ float bflo(unsigned w) { return __uint_as_float(w << 16); }
__device__ __forceinline__ float bfhi(unsigned w) { return __uint_as_float(w & 0xffff0000u); }
__device__ __forceinline__ unsigned pk2(float lo, float hi) { return pg8::cvt_pk_bf16(lo, hi); }
__device__ __forceinline__ float shfl_xor_f(float v, int mask, int lane) { return __int_as_float(__builtin_amdgcn_ds_bpermute((lane ^ mask) << 2, __float_as_int(v))); }
__device__ __forceinline__ float shfl_idx_f(float v, int src) { return __int_as_float(__builtin_amdgcn_ds_bpermute(src << 2, __float_as_int(v))); }
__device__ __forceinline__ float wave_sum(float v, int lane) {
#pragma unroll
  for (int o = 32; o >= 1; o >>= 1) v += shfl_xor_f(v, o, lane); return v; }
__device__ __forceinline__ void wave_fence() { asm volatile("s_waitcnt lgkmcnt(0)" ::: "memory"); __builtin_amdgcn_wave_barrier(); }
__device__ __forceinline__ float sigmoidf_(float v) { return __builtin_amdgcn_rcpf(1.f + __expf(-v)); }

__device__ __forceinline__ void transpose_tile(const float* __restrict__ src, int N, bf16_t* __restrict__ dst, int ldd, int koff, int k0, int n0, float* tl) {
  const int tid = TIDX(), c = tid & 63, r = tid >> 6;
#pragma unroll
  for (int i = 0; i < 8; ++i) { const int k = r + 8 * i; tl[k * 65 + c] = src[(size_t)(k0 + k) * N + n0 + c]; }
  __syncthreads();
  const int n = tid >> 3, kb = (tid & 7) * 8;
  u32x4 w;
  w.x = pk2(tl[(kb + 0) * 65 + n], tl[(kb + 1) * 65 + n]); w.y = pk2(tl[(kb + 2) * 65 + n], tl[(kb + 3) * 65 + n]);
  w.z = pk2(tl[(kb + 4) * 65 + n], tl[(kb + 5) * 65 + n]); w.w = pk2(tl[(kb + 6) * 65 + n], tl[(kb + 7) * 65 + n]);
  *(u32x4*)(dst + (size_t)(n0 + n) * ldd + koff + k0 + kb) = w;
  __syncthreads();
}
__device__ __forceinline__ void convert_small(const Params& p, int l, int item, float* tl) {
  unsigned char* base = p.ws + (size_t)l * SM_LAYER;
  if (item < 128) { transpose_tile(p.w_pa + (size_t)l * 512 * 1024, 1024, (bf16_t*)(base + OFF_WCAT), 1536, 0, (item >> 4) * 64, (item & 15) * 64, tl); }
  else if (item < 384) { const int it = item - 128; transpose_tile(p.w_pb + (size_t)l * 1024 * 1024, 1024, (bf16_t*)(base + OFF_WCAT), 1536, 512, (it >> 4) * 64, (it & 15) * 64, tl); }
  else if (item < 640) { const int it = item - 384; transpose_tile(p.w_o + (size_t)l * 1024 * 1024, 1024, (bf16_t*)(base + OFF_WO), 1024, 0, (it >> 4) * 64, (it & 15) * 64, tl); }
  else if (item < 656) { const int h = item - 640; transpose_tile(p.w_rg + (size_t)l * 65536 + h * 4096, 64, (bf16_t*)(base + OFF_WRG) + h * 4096, 64, 0, 0, 0, tl); }
  else { const int h = item - 656; transpose_tile(p.w_ig + (size_t)l * 65536 + h * 4096, 64, (bf16_t*)(base + OFF_WIG) + h * 4096, 64, 0, 0, 0, tl); }
}
__device__ __forceinline__ void convert_win(const Params& p, int l, int item, float* tl) {
  const int kt = item / 144, nt = item % 144;
  transpose_tile(p.w_in + (size_t)l * 1024 * 9216, 9216, (bf16_t*)(p.ws + WS_WIN), 1024, 0, kt * 64, nt * 64, tl);
}
__device__ __forceinline__ void mod_item(const Params& p, int l, int cgp, float* red) {
  const int tid = TIDX(), w = tid >> 6, lane = tid & 63;
  const float* W = p.w_mod + (size_t)l * 1024 * 3072;
  float* mod = (float*)(p.ws + WS_MOD);
  const int col = cgp * 64 + lane;
  float a0 = 0.f, a1 = 0.f;
  for (int k = w * 128; k < w * 128 + 128; ++k) {
    const float c0 = p.c[k], c1 = p.c[1024 + k];
    const float s0 = c0 * sigmoidf_(c0), s1 = c1 * sigmoidf_(c1);
    const float wv = W[(size_t)k * 3072 + col];
    a0 += s0 * wv; a1 += s1 * wv;
  }
  red[(w * 2 + 0) * 64 + lane] = a0; red[(w * 2 + 1) * 64 + lane] = a1;
  __syncthreads();
  if (tid < 128) { const int b = tid >> 6; float s = 0.f;
#pragma unroll
    for (int ww = 0; ww < 8; ++ww) s += red[(ww * 2 + b) * 64 + lane];
    mod[(l * 2 + b) * 3072 + col] = s + p.b_mod[l * 3072 + col]; }
  __syncthreads();
}
__device__ __forceinline__ void prologue_phase(const Params& p, unsigned char* smem) {
  float* tl = (float*)smem;
  for (int it = BIDX(); it < 96 + 2 * 672 + 2304; it += gridDim.x) {
    if (it < 96) mod_item(p, it / 48, it % 48, tl);
    else if (it < 96 + 1344) { const int j = it - 96; convert_small(p, j / 672, j % 672, tl); }
    else convert_win(p, 0, it - 96 - 1344, tl);
  }
}

__device__ __forceinline__ void prenorm_phase(const Params& p, const float* xsrc, int l) {
  const int lane = TIDX() & 63, nw = gridDim.x * 8;
  const float* gp = p.g_pre + l * 1024; const float* md = (const float*)(p.ws + WS_MOD) + l * 2 * 3072;
  bf16_t* h = (bf16_t*)(p.ws + WS_H);
  for (int row = BIDX() * 8 + (TIDX() >> 6); row < MTOK; row += nw) {
    const int b = row >> 13;
    const float4* xr = (const float4*)(xsrc + (size_t)row * 1024);
    float4 v[4]; float ss = 0.f;
#pragma unroll
    for (int i = 0; i < 4; ++i) { v[i] = xr[lane + 64 * i]; ss += v[i].x * v[i].x + v[i].y * v[i].y + v[i].z * v[i].z + v[i].w * v[i].w; }
    ss = wave_sum(ss, lane);
    const float rstd = rsqrtf(ss * (1.f / 1024.f) + 1e-6f);
#pragma unroll
    for (int i = 0; i < 4; ++i) { const int col = (lane + 64 * i) * 4;
      const float4 g = *(const float4*)(gp + col), sh = *(const float4*)(md + b * 3072 + col), sc = *(const float4*)(md + b * 3072 + 1024 + col);
      u32x2 w; w.x = pk2(v[i].x * rstd * g.x * (1.f + sc.x) + sh.x, v[i].y * rstd * g.y * (1.f + sc.y) + sh.y);
      w.y = pk2(v[i].z * rstd * g.z * (1.f + sc.z) + sh.z, v[i].w * rstd * g.w * (1.f + sc.w) + sh.w);
      *(u32x2*)(h + (size_t)row * 1024 + col) = w; }
  }
}

__device__ __forceinline__ float actf(float v, int act, float sc) { if (act == 0) return v * sc; const float r = sigmoidf_(v); return act == 1 ? v * r : r; }
template <int MODE> struct EpiT {
  static constexpr bool PERM = true, AFTER_DRAIN = false; static constexpr int MID_T = -1;
  unsigned char* ws;
  __device__ __forceinline__ void operator()(const f32x4 (&acc)[2][2][4][2], const pg8::Unit& u, int wr, int wc, int fr, int fq) const {
    bf16_t* dst; int ldc, pn0, act; float sc = 1.0f;
    if (MODE == 0) { if (u.pn < 18) { dst = (bf16_t*)(ws + WS_R); ldc = 4608; pn0 = 0; act = 0; if (u.pn < 6) sc = 0.08838834764831845f * 1.4426950408889634f; }
                     else { dst = (bf16_t*)(ws + WS_GATT); ldc = 512; pn0 = 18; act = 1; } }
    else if (MODE == 1) { if (u.pn < 4) { dst = (bf16_t*)(ws + WS_R); ldc = 1024; pn0 = 0; act = 0; }
                          else if (u.pn < 8) { dst = (bf16_t*)(ws + WS_R + 32 * MiB); ldc = 1024; pn0 = 4; act = 1; }
                          else { dst = (bf16_t*)(ws + WS_R + 64 * MiB); ldc = 2048; pn0 = 8; act = 2; } }
    else { dst = (bf16_t*)(ws + WS_R); ldc = 1024; pn0 = 0; act = 0; }
    asm volatile("" : "+v"(fr), "+v"(fq));
    const int row0 = u.pm * 256 + wr * 64 + fr, col0 = (u.pn - pn0) * 256 + wc * 32 + 8 * fq;
#pragma unroll
    for (int ai = 0; ai < 2; ++ai)
#pragma unroll
      for (int m = 0; m < 4; ++m) { bf16_t* rowp = dst + (size_t)(row0 + ai * 128 + m * 16) * ldc + col0;
#pragma unroll
        for (int bj = 0; bj < 2; ++bj) { const f32x4 v0 = acc[ai][bj][m][0], v1 = acc[ai][bj][m][1];
          u32x4 w; w.x = pk2(actf(v0[0], act, sc), actf(v0[1], act, sc)); w.y = pk2(actf(v0[2], act, sc), actf(v0[3], act, sc));
          w.z = pk2(actf(v1[0], act, sc), actf(v1[1], act, sc)); w.w = pk2(actf(v1[2], act, sc), actf(v1[3], act, sc));
          *(u32x4*)(rowp + bj * 128) = w; } }
  }
  __device__ __forceinline__ void mid(f32x4 (&)[2][2][4][2], const pg8::Unit&, int, int, int, int) const {}
};
struct EpiZ {
  static constexpr bool PERM = true, AFTER_DRAIN = false; static constexpr int MID_T = 8;
  const bf16_t* mg; bf16_t* z;
  __device__ __forceinline__ void mid(f32x4 (&acc)[2][2][4][2], const pg8::Unit& u, int wr, int wc, int fr, int fq) const {
    asm volatile("" : "+v"(fr), "+v"(fq));
    const int row0 = u.pm * 256 + wr * 64 + fr, col0 = u.pn * 256 + wc * 32 + 8 * fq;
#pragma unroll
    for (int ai = 0; ai < 2; ++ai)
#pragma unroll
      for (int m = 0; m < 4; ++m) { const bf16_t* rp = mg + (size_t)(row0 + ai * 128 + m * 16) * 2048 + col0;
#pragma unroll
        for (int bj = 0; bj < 2; ++bj) { const u32x4 ga = *(const u32x4*)(rp + bj * 128), gb = *(const u32x4*)(rp + 1024 + bj * 128);
          f32x4 r0, r1;
          r0[0] = bflo(ga.x) * __builtin_amdgcn_rcpf(bflo(gb.x)); r0[1] = bfhi(ga.x) * __builtin_amdgcn_rcpf(bfhi(gb.x));
          r0[2] = bflo(ga.y) * __builtin_amdgcn_rcpf(bflo(gb.y)); r0[3] = bfhi(ga.y) * __builtin_amdgcn_rcpf(bfhi(gb.y));
          r1[0] = bflo(ga.z) * __builtin_amdgcn_rcpf(bflo(gb.z)); r1[1] = bfhi(ga.z) * __builtin_amdgcn_rcpf(bfhi(gb.z));
          r1[2] = bflo(ga.w) * __builtin_amdgcn_rcpf(bflo(gb.w)); r1[3] = bfhi(ga.w) * __builtin_amdgcn_rcpf(bfhi(gb.w));
          acc[ai][bj][m][0] *= r0; acc[ai][bj][m][1] *= r1; asm volatile("" ::: "memory"); __builtin_amdgcn_sched_barrier(0); } }
  }
  __device__ __forceinline__ void operator()(const f32x4 (&acc)[2][2][4][2], const pg8::Unit& u, int wr, int wc, int fr, int fq) const {
    asm volatile("" : "+v"(fr), "+v"(fq));
    const int row0 = u.pm * 256 + wr * 64 + fr, col0 = u.pn * 256 + wc * 32 + 8 * fq;
#pragma unroll
    for (int ai = 0; ai < 2; ++ai)
#pragma unroll
      for (int m = 0; m < 4; ++m) { const size_t ro = (size_t)(row0 + ai * 128 + m * 16);
#pragma unroll
        for (int bj = 0; bj < 2; ++bj) { const u32x4 gb = *(const u32x4*)(mg + ro * 2048 + 1024 + col0 + bj * 128);
          const f32x4 v0 = acc[ai][bj][m][0], v1 = acc[ai][bj][m][1];
          u32x4 w; w.x = pk2(v0[0] * bflo(gb.x), v0[1] * bfhi(gb.x)); w.y = pk2(v0[2] * bflo(gb.y), v0[3] * bfhi(gb.y));
          w.z = pk2(v1[0] * bflo(gb.z), v1[1] * bfhi(gb.z)); w.w = pk2(v1[2] * bflo(gb.w), v1[3] * bfhi(gb.w));
          *(u32x4*)(z + ro * 1024 + col0 + bj * 128) = w; }
        asm volatile("" ::: "memory"); }
  }
};

__device__ __forceinline__ void attn_phase(const Params& p, unsigned char* smem) {
  LAS unsigned char* lds = (LAS unsigned char*)smem;
  const int tid = TIDX(), lane = tid & 63, w = tid >> 6, g4 = lane >> 4, l15 = lane & 15;
  constexpr int KSTR = 272, VOFF = 256 * 272, VSTR = 288;
  for (int i = tid; i < 16 * VSTR / 4; i += 512) ((LAS unsigned*)(lds + VOFF + 256 * VSTR))[i] = 0u;
  const bf16_t* qkv = (const bf16_t*)(p.ws + WS_R);
  bf16_t* acat = (bf16_t*)(p.ws + WS_ACAT);
  float* mbuf = (float*)(p.ws + WS_ML); float* lbuf = mbuf + 3 * MTOK * 4;
  for (int item = BIDX(); item < 1536; item += gridDim.x) {
    const int blk = item & 63, hh = (item >> 6) & 3, bg = item >> 8, g = bg % 3, b = bg / 3;
    const int dsh = 2 * g, dil = 1 << dsh, nb = 64 >> dsh;
    const int r = blk / nb, n = blk % nb;
    const size_t tokbase = (size_t)b * SEQ + r;
    const bf16_t* qp = qkv + g * 512 + hh * 128; const bf16_t* kp = qp + 1536; const bf16_t* vp = qp + 3072;
    bf16x8 qf[4];
    { const size_t tq = tokbase + (size_t)dil * (n * 128 + 16 * w + l15);
#pragma unroll
      for (int kk = 0; kk < 4; ++kk) qf[kk] = *(const bf16x8*)(qp + tq * 4608 + 32 * kk + 8 * g4); }
    __syncthreads();
#pragma unroll
    for (int it = 0; it < 8; ++it) { const int cid = it * 512 + tid, row = cid >> 4, ch = cid & 15;
      int idx = (n - 1) * 128 + row; if (idx < 0) idx = 0;
      const size_t tk = tokbase + (size_t)dil * idx;
      const u32x4 kv = *(const u32x4*)(kp + tk * 4608 + ch * 8), vv = *(const u32x4*)(vp + tk * 4608 + ch * 8);
      *(LAS u32x4*)(lds + row * KSTR + ch * 16) = kv; *(LAS u32x4*)(lds + VOFF + row * VSTR + ch * 16) = vv; }
    __syncthreads();
    f32x4 S[9];
#pragma unroll
    for (int T = 0; T < 9; ++T) { f32x4 a = {0.f, 0.f, 0.f, 0.f};
#pragma unroll
      for (int kk = 0; kk < 4; ++kk) { const bf16x8 kf = *(const LAS bf16x8*)(lds + (16 * (w + T) + l15) * KSTR + 64 * kk + 16 * g4);
        a = __builtin_amdgcn_mfma_f32_16x16x32_bf16(kf, qf[kk], a, 0, 0, 0); }
      S[T] = a; }
    float mx = -1e30f;
#pragma unroll
    for (int T = 0; T < 9; ++T)
#pragma unroll
      for (int jj = 0; jj < 4; ++jj) { const int dj = 16 * T + 4 * g4 + jj - l15, j = 16 * (w + T) + 4 * g4 + jj;
        const bool valid = (dj >= 0) && (dj <= 128) && (n > 0 || j >= 128);
        const float s = valid ? S[T][jj] : -1e30f; S[T][jj] = s; mx = fmaxf(mx, s); }
    mx = fmaxf(mx, shfl_xor_f(mx, 16, lane)); mx = fmaxf(mx, shfl_xor_f(mx, 32, lane));
    float lsum = 0.f;
#pragma unroll
    for (int T = 0; T < 9; ++T)
#pragma unroll
      for (int jj = 0; jj < 4; ++jj) { const float pv = __builtin_amdgcn_exp2f(S[T][jj] - mx); S[T][jj] = pv; lsum += pv; }
    lsum += shfl_xor_f(lsum, 16, lane); lsum += shfl_xor_f(lsum, 32, lane);
    f32x4 O[8];
#pragma unroll
    for (int dt = 0; dt < 8; ++dt) O[dt] = (f32x4){0.f, 0.f, 0.f, 0.f};
#pragma unroll
    for (int s5 = 0; s5 < 5; ++s5) { const int T0 = 2 * s5, T1 = 2 * s5 + 1;
      u32x4 pw; pw.x = pk2(S[T0][0], S[T0][1]); pw.y = pk2(S[T0][2], S[T0][3]);
      if (T1 < 9) { pw.z = pk2(S[T1 < 9 ? T1 : 0][0], S[T1 < 9 ? T1 : 0][1]); pw.w = pk2(S[T1 < 9 ? T1 : 0][2], S[T1 < 9 ? T1 : 0][3]); } else { pw.z = 0u; pw.w = 0u; }
      const bf16x8 pf = __builtin_bit_cast(bf16x8, pw);
      const int ra = 16 * (w + T0) + 4 * g4 + (l15 >> 2), rb = 16 * (w + T1) + 4 * g4 + (l15 >> 2);
#pragma unroll
      for (int dt = 0; dt < 8; ++dt) { const int cb = (16 * dt + 4 * (l15 & 3)) * 2;
        const v4i16_t va = __builtin_amdgcn_ds_read_tr16_b64_v4i16((LAS v4i16_t*)(lds + VOFF + ra * VSTR + cb));
        const v4i16_t vb = __builtin_amdgcn_ds_read_tr16_b64_v4i16((LAS v4i16_t*)(lds + VOFF + rb * VSTR + cb));
        bf16x8 vf; vf[0] = va[0]; vf[1] = va[1]; vf[2] = va[2]; vf[3] = va[3]; vf[4] = vb[0]; vf[5] = vb[1]; vf[6] = vb[2]; vf[7] = vb[3];
        O[dt] = __builtin_amdgcn_mfma_f32_16x16x32_bf16(pf, vf, O[dt], 0, 0, 0); } }
#pragma unroll
    for (int jj = 0; jj < 4; ++jj) { const float lq = shfl_idx_f(lsum, 4 * g4 + jj); const float inv = 1.0f / lq;
      const size_t t = tokbase + (size_t)dil * (n * 128 + 16 * w + 4 * g4 + jj);
      bf16_t* op = acat + t * 1536 + g * 512 + hh * 128 + l15;
#pragma unroll
      for (int dt = 0; dt < 8; ++dt) op[16 * dt] = (bf16_t)(pk2(O[dt][jj] * inv, 0.f) & 0xffffu); }
    if (g4 == 0) { const size_t t = tokbase + (size_t)dil * (n * 128 + 16 * w + l15);
      mbuf[((size_t)g * MTOK + t) * 4 + hh] = mx; lbuf[((size_t)g * MTOK + t) * 4 + hh] = lsum; }
  }
}

__device__ __forceinline__ void mix_phase(const Params& p) {
  const int lane = TIDX() & 63, nw = gridDim.x * 8, c = lane * 8, j = lane >> 4;
  bf16_t* acat = (bf16_t*)(p.ws + WS_ACAT); const bf16_t* gatt = (const bf16_t*)(p.ws + WS_GATT);
  const float* mbuf = (const float*)(p.ws + WS_ML); const float* lbuf = mbuf + 3 * MTOK * 4;
  for (int t = BIDX() * 8 + (TIDX() >> 6); t < MTOK; t += nw) {
    const float m0 = mbuf[((size_t)0 * MTOK + t) * 4 + j], m1 = mbuf[((size_t)1 * MTOK + t) * 4 + j], m2 = mbuf[((size_t)2 * MTOK + t) * 4 + j];
    const float l0 = lbuf[((size_t)0 * MTOK + t) * 4 + j], l1 = lbuf[((size_t)1 * MTOK + t) * 4 + j], l2 = lbuf[((size_t)2 * MTOK + t) * 4 + j];
    const float mm = fmaxf(m0, fmaxf(m1, m2));
    float w0 = l0 * __builtin_amdgcn_exp2f(m0 - mm), w1 = l1 * __builtin_amdgcn_exp2f(m1 - mm), w2 = l2 * __builtin_amdgcn_exp2f(m2 - mm);
    const float inv = 1.0f / (w0 + w1 + w2); w0 *= inv; w1 *= inv; w2 *= inv;
    bf16_t* ap = acat + (size_t)t * 1536 + c;
    const u32x4 o0 = *(const u32x4*)ap, o1 = *(const u32x4*)(ap + 512), o2 = *(const u32x4*)(ap + 1024), ga = *(const u32x4*)(gatt + (size_t)t * 512 + c);
    u32x4 r;
    r.x = pk2((w0 * bflo(o0.x) + w1 * bflo(o1.x) + w2 * bflo(o2.x)) * bflo(ga.x), (w0 * bfhi(o0.x) + w1 * bfhi(o1.x) + w2 * bfhi(o2.x)) * bfhi(ga.x));
    r.y = pk2((w0 * bflo(o0.y) + w1 * bflo(o1.y) + w2 * bflo(o2.y)) * bflo(ga.y), (w0 * bfhi(o0.y) + w1 * bfhi(o1.y) + w2 * bfhi(o2.y)) * bfhi(ga.y));
    r.z = pk2((w0 * bflo(o0.z) + w1 * bflo(o1.z) + w2 * bflo(o2.z)) * bflo(ga.z), (w0 * bfhi(o0.z) + w1 * bfhi(o1.z) + w2 * bfhi(o2.z)) * bfhi(ga.z));
    r.w = pk2((w0 * bflo(o0.w) + w1 * bflo(o1.w) + w2 * bflo(o2.w)) * bflo(ga.w), (w0 * bfhi(o0.w) + w1 * bfhi(o1.w) + w2 * bfhi(o2.w)) * bfhi(ga.w));
    *(u32x4*)ap = r;
  }
}

template <int PASS> __device__ __forceinline__ void lru_phase(const Params& p, int l, unsigned char* smem) {
  const int tid = TIDX(), lane = tid & 63, w = tid >> 6, g4 = lane >> 4, l15 = lane & 15;
  LAS unsigned char* my = (LAS unsigned char*)smem + w * 14848;
  LAS float* Uc = (LAS float*)(my + 2304); LAS float* Rp = (LAS float*)(my + 6464); LAS float* Ip = (LAS float*)(my + 10624);
  const bf16_t* ub = (const bf16_t*)(p.ws + WS_R); const bf16_t* glru = (const bf16_t*)(p.ws + WS_R + 32 * MiB);
  bf16_t* acat = (bf16_t*)(p.ws + WS_ACAT);
  float* aggA = (float*)(p.ws + WS_AGG); float* aggH = aggA + 2 * 64 * 1024;
  const bf16_t* WrgT = (const bf16_t*)(p.ws + (size_t)l * SM_LAYER + OFF_WRG); const bf16_t* WigT = (const bf16_t*)(p.ws + (size_t)l * SM_LAYER + OFF_WIG);
  const int tt = lane >> 2, c16 = (lane & 3) * 16;
  for (int wi = BIDX() * 8 + w; wi < 2048; wi += gridDim.x * 8) {
    const int hb = wi & 15, piece = (wi >> 4) & 63, b = wi >> 10;
    const int ch = hb * 64 + lane, chc = hb * 64 + c16;
    const float brg = p.b_rg[l * 1024 + ch], big = p.b_ig[l * 1024 + ch];
    const float sp = -8.0f * log1pf(expf(-p.lam[l * 1024 + ch]));
    float hc = 0.f, Aagg = 1.f;
    if (PASS == 2) { for (int pc = 0; pc < piece; ++pc) { const float a = aggA[(size_t)(b * 64 + pc) * 1024 + ch], hh = aggH[(size_t)(b * 64 + pc) * 1024 + ch]; hc = a * hc + hh; } }
    for (int sub = 0; sub < 8; ++sub) {
      const int sbase = piece * 128 + sub * 16;
      const size_t t0 = (size_t)b * SEQ + sbase;
      float uc[16];
      { const float4* cbp = (const float4*)(p.conv_b + l * 1024 + chc);
#pragma unroll
        for (int q = 0; q < 4; ++q) { const float4 v = cbp[q]; uc[4 * q] = v.x; uc[4 * q + 1] = v.y; uc[4 * q + 2] = v.z; uc[4 * q + 3] = v.w; } }
#pragma unroll
      for (int j = 0; j < 4; ++j) {
        if (sbase + tt - j >= 0) {
          const bf16_t* up = ub + (t0 + tt - j) * 1024 + chc;
          const u32x4 ua = *(const u32x4*)up, uv = *(const u32x4*)(up + 8);
          const float4* cwp = (const float4*)(p.conv_w + (size_t)(l * 4 + j) * 1024 + chc);
          const float4 w0 = cwp[0], w1 = cwp[1], w2 = cwp[2], w3 = cwp[3];
          uc[0] += w0.x * bflo(ua.x); uc[1] += w0.y * bfhi(ua.x); uc[2] += w0.z * bflo(ua.y); uc[3] += w0.w * bfhi(ua.y);
          uc[4] += w1.x * bflo(ua.z); uc[5] += w1.y * bfhi(ua.z); uc[6] += w1.z * bflo(ua.w); uc[7] += w1.w * bfhi(ua.w);
          uc[8] += w2.x * bflo(uv.x); uc[9] += w2.y * bfhi(uv.x); uc[10] += w2.z * bflo(uv.y); uc[11] += w2.w * bfhi(uv.y);
          uc[12] += w3.x * bflo(uv.z); uc[13] += w3.y * bfhi(uv.z); uc[14] += w3.z * bflo(uv.w); uc[15] += w3.w * bfhi(uv.w);
        }
      }
      { u32x4 a0, a1; a0.x = pk2(uc[0], uc[1]); a0.y = pk2(uc[2], uc[3]); a0.z = pk2(uc[4], uc[5]); a0.w = pk2(uc[6], uc[7]);
        a1.x = pk2(uc[8], uc[9]); a1.y = pk2(uc[10], uc[11]); a1.z = pk2(uc[12], uc[13]); a1.w = pk2(uc[14], uc[15]);
        *(LAS u32x4*)(my + tt * 144 + c16 * 2) = a0; *(LAS u32x4*)(my + tt * 144 + c16 * 2 + 16) = a1;
#pragma unroll
        for (int e = 0; e < 16; ++e) Uc[tt * 65 + c16 + e] = uc[e]; }
      wave_fence();
      { bf16x8 af[2];
#pragma unroll
        for (int kk = 0; kk < 2; ++kk) af[kk] = *(const LAS bf16x8*)(my + l15 * 144 + (32 * kk + 8 * g4) * 2);
#pragma unroll
        for (int nt = 0; nt < 4; ++nt) { f32x4 ar = {0.f, 0.f, 0.f, 0.f}, ai = {0.f, 0.f, 0.f, 0.f};
#pragma unroll
          for (int kk = 0; kk < 2; ++kk) { const size_t wo = (size_t)(hb * 64 + 16 * nt + l15) * 64 + 32 * kk + 8 * g4;
            const bf16x8 wr_ = *(const bf16x8*)(WrgT + wo), wi_ = *(const bf16x8*)(WigT + wo);
            ar = __builtin_amdgcn_mfma_f32_16x16x32_bf16(af[kk], wr_, ar, 0, 0, 0); ai = __builtin_amdgcn_mfma_f32_16x16x32_bf16(af[kk], wi_, ai, 0, 0, 0); }
#pragma unroll
          for (int jj = 0; jj < 4; ++jj) { Rp[(4 * g4 + jj) * 65 + 16 * nt + l15] = ar[jj]; Ip[(4 * g4 + jj) * 65 + 16 * nt + l15] = ai[jj]; } } }
      wave_fence();
#pragma unroll 4
      for (int t2 = 0; t2 < 16; ++t2) {
        const float rg = sigmoidf_(Rp[t2 * 65 + lane] + brg), ig = sigmoidf_(Ip[t2 * 65 + lane] + big), uu = Uc[t2 * 65 + lane];
        const float la = sp * rg, a = __expf(la), xin = sqrtf(-expm1f(2.0f * la)) * (ig * uu);
        hc = a * hc + xin;
        if (PASS == 1) Aagg *= a; else Uc[t2 * 65 + lane] = hc;
      }
      if (PASS == 2) {
        wave_fence();
        const bf16_t* gp = glru + (t0 + tt) * 1024 + chc; const u32x4 ga = *(const u32x4*)gp, gv = *(const u32x4*)(gp + 8);
        float hv[16];
#pragma unroll
        for (int e = 0; e < 16; ++e) hv[e] = Uc[tt * 65 + c16 + e];
        u32x4 o0, o1;
        o0.x = pk2(hv[0] * bflo(ga.x), hv[1] * bfhi(ga.x)); o0.y = pk2(hv[2] * bflo(ga.y), hv[3] * bfhi(ga.y)); o0.z = pk2(hv[4] * bflo(ga.z), hv[5] * bfhi(ga.z)); o0.w = pk2(hv[6] * bflo(ga.w), hv[7] * bfhi(ga.w));
        o1.x = pk2(hv[8] * bflo(gv.x), hv[9] * bfhi(gv.x)); o1.y = pk2(hv[10] * bflo(gv.y), hv[11] * bfhi(gv.y)); o1.z = pk2(hv[12] * bflo(gv.z), hv[13] * bfhi(gv.z)); o1.w = pk2(hv[14] * bflo(gv.w), hv[15] * bfhi(gv.w));
        bf16_t* op = acat + (t0 + tt) * 1536 + 512 + chc;
        *(u32x4*)op = o0; *(u32x4*)(op + 8) = o1;
      }
      wave_fence();
    }
    if (PASS == 1) { aggA[(size_t)(b * 64 + piece) * 1024 + ch] = Aagg; aggH[(size_t)(b * 64 + piece) * 1024 + ch] = hc; }
  }
}

__device__ __forceinline__ void post_phase(const Params& p, int l, const float* xold, float* xnew, bool make_h) {
  const int lane = TIDX() & 63, nw = gridDim.x * 8;
  const bf16_t* ob = (const bf16_t*)(p.ws + WS_R);
  const float* gpo = p.g_post + l * 1024; const float* md = (const float*)(p.ws + WS_MOD) + l * 2 * 3072;
  const float* gpn = p.g_pre + (l + 1) * 1024; const float* mdn = md + 2 * 3072;
  bf16_t* h = (bf16_t*)(p.ws + WS_H);
  for (int row = BIDX() * 8 + (TIDX() >> 6); row < MTOK; row += nw) {
    const int b = row >> 13;
    float4 o[4]; float ss = 0.f;
#pragma unroll
    for (int i = 0; i < 4; ++i) { const u32x2 wv = *(const u32x2*)(ob + (size_t)row * 1024 + (lane + 64 * i) * 4);
      o[i] = make_float4(bflo(wv.x), bfhi(wv.x), bflo(wv.y), bfhi(wv.y)); ss += o[i].x * o[i].x + o[i].y * o[i].y + o[i].z * o[i].z + o[i].w * o[i].w; }
    ss = wave_sum(ss, lane);
    const float rstd = rsqrtf(ss * (1.f / 1024.f) + 1e-6f);
    float4 y[4]; float s2 = 0.f;
#pragma unroll
    for (int i = 0; i < 4; ++i) { const int col = (lane + 64 * i) * 4;
      const float4 xv = *(const float4*)(xold + (size_t)row * 1024 + col), g = *(const float4*)(gpo + col), gt = *(const float4*)(md + b * 3072 + 2048 + col);
      y[i].x = xv.x + gt.x * (o[i].x * rstd * g.x); y[i].y = xv.y + gt.y * (o[i].y * rstd * g.y); y[i].z = xv.z + gt.z * (o[i].z * rstd * g.z); y[i].w = xv.w + gt.w * (o[i].w * rstd * g.w);
      *(float4*)(xnew + (size_t)row * 1024 + col) = y[i];
      s2 += y[i].x * y[i].x + y[i].y * y[i].y + y[i].z * y[i].z + y[i].w * y[i].w; }
    if (make_h) {
      s2 = wave_sum(s2, lane);
      const float r2 = rsqrtf(s2 * (1.f / 1024.f) + 1e-6f);
#pragma unroll
      for (int i = 0; i < 4; ++i) { const int col = (lane + 64 * i) * 4;
        const float4 g = *(const float4*)(gpn + col), sh = *(const float4*)(mdn + b * 3072 + col), sc = *(const float4*)(mdn + b * 3072 + 1024 + col);
        u32x2 w; w.x = pk2(y[i].x * r2 * g.x * (1.f + sc.x) + sh.x, y[i].y * r2 * g.y * (1.f + sc.y) + sh.y);
        w.y = pk2(y[i].z * r2 * g.z * (1.f + sc.z) + sh.z, y[i].w * r2 * g.w * (1.f + sc.w) + sh.w);
        *(u32x2*)(h + (size_t)row * 1024 + col) = w; }
    }
  }
}

__global__ void __launch_bounds__(512, 2) hybrid_fwd(Params p) {
  extern __shared__ __attribute__((aligned(16))) unsigned char smem[];
  cg::grid_group grid = cg::this_grid();
  PG8_LAS unsigned char* lds = (PG8_LAS unsigned char*)smem;
  for (int ph = p.ph_lo; ph < p.ph_hi; ++ph) {
    if (ph == 0) prologue_phase(p, smem);
    else if (ph == 1) prenorm_phase(p, p.x, 0);
    else {
      const int l = (ph - 2) / 9, k = (ph - 2) % 9;
      bf16_t* R = (bf16_t*)(p.ws + WS_R);
      if (k == 0) {
        pg8::Gemm g; g.A = (const bf16_t*)(p.ws + WS_H); g.Bt = (const bf16_t*)(p.ws + WS_WIN); g.M = MTOK; g.N = 5120; g.K = 1024;
        EpiT<0> E; E.ws = p.ws; pg8::StaticOrder S; S.init(g.M, g.N, (int)gridDim.x, (int)BIDX());
        pg8::gemm_phase<EpiT<0>, pg8::StaticOrder, false>(lds, g, S, E, nullptr);
      } else if (k == 3) {
        pg8::Gemm g; g.A = (const bf16_t*)(p.ws + WS_H); g.Bt = (const bf16_t*)(p.ws + WS_WIN) + (size_t)5120 * 1024; g.M = MTOK; g.N = 4096; g.K = 1024;
        EpiT<1> E; E.ws = p.ws; pg8::StaticOrder S; S.init(g.M, g.N, (int)gridDim.x, (int)BIDX());
        pg8::gemm_phase<EpiT<1>, pg8::StaticOrder, false>(lds, g, S, E, nullptr);
      } else if (k == 7) {
        pg8::Gemm g; g.A = (const bf16_t*)(p.ws + WS_H); g.Bt = (const bf16_t*)(p.ws + (size_t)l * SM_LAYER + OFF_WO); g.M = MTOK; g.N = 1024; g.K = 1024;
        EpiT<2> E; E.ws = p.ws; pg8::StaticOrder S; S.init(g.M, g.N, (int)gridDim.x, (int)BIDX());
        pg8::gemm_phase<EpiT<2>, pg8::StaticOrder, false>(lds, g, S, E, nullptr);
      } else if (k == 6) {
        pg8::Gemm g; g.A = (const bf16_t*)(p.ws + WS_ACAT); g.Bt = (const bf16_t*)(p.ws + (size_t)l * SM_LAYER + OFF_WCAT); g.M = MTOK; g.N = 1024; g.K = 1536;
        EpiZ E; E.mg = (const bf16_t*)(p.ws + WS_R + 64 * MiB); E.z = (bf16_t*)(p.ws + WS_H);
        pg8::StaticOrder S; S.init(g.M, g.N, (int)gridDim.x, (int)BIDX());
        pg8::gemm_phase<EpiZ, pg8::StaticOrder, false>(lds, g, S, E, nullptr);
      } else if (k == 1) attn_phase(p, smem);
      else if (k == 2) mix_phase(p);
      else if (k == 4) { lru_phase<1>(p, l, smem);
        if (l == 0) { __syncthreads(); for (int it = BIDX(); it < 2304; it += gridDim.x) convert_win(p, 1, it, (float*)smem); } }
      else if (k == 5) lru_phase<2>(p, l, smem);
      else { const float* xo = (l == 0) ? p.x : p.out; post_phase(p, l, xo, p.out, l == 0); }
    }
    if (ph + 1 < p.ph_hi) grid.sync();
  }
}

extern "C" void kernel_launch(void* const* d_in, const int* in_sizes, int n_in, void* d_out, int out_size, void* d_ws, size_t ws_size, hipStream_t stream) {
  static int grid_blocks = 0;
  if (!grid_blocks) {
    (void)hipFuncSetAttribute((const void*)hybrid_fwd, hipFuncAttributeMaxDynamicSharedMemorySize, LDS_BYTES);
    int dev = 0, cus = 0, per_cu = 0;
    (void)hipGetDevice(&dev);
    (void)hipDeviceGetAttribute(&cus, hipDeviceAttributeMultiprocessorCount, dev);
    (void)hipOccupancyMaxActiveBlocksPerMultiprocessor(&per_cu, hybrid_fwd, 512, LDS_BYTES);
    grid_blocks = cus * (per_cu > 0 ? 1 : 0);
    if (grid_blocks > 256) grid_blocks = 256;
  }
  if (ws_size < WS_END || grid_blocks <= 0) { fprintf(stderr, "kernel_launch: workspace %zu < %zu or no resident block\n", ws_size, (size_t)WS_END); return; }
  Params p{};
  p.x = (const float*)d_in[0]; p.c = (const float*)d_in[1]; p.w_mod = (const float*)d_in[2]; p.b_mod = (const float*)d_in[3]; p.g_pre = (const float*)d_in[4];
  p.w_in = (const float*)d_in[5]; p.conv_w = (const float*)d_in[6]; p.conv_b = (const float*)d_in[7]; p.w_rg = (const float*)d_in[8]; p.b_rg = (const float*)d_in[9];
  p.w_ig = (const float*)d_in[10]; p.b_ig = (const float*)d_in[11]; p.lam = (const float*)d_in[12]; p.w_pa = (const float*)d_in[13]; p.w_pb = (const float*)d_in[14];
  p.w_o = (const float*)d_in[15]; p.g_post = (const float*)d_in[16];
  p.out = (float*)d_out; p.ws = (unsigned char*)d_ws; p.ph_lo = 0; p.ph_hi = NPHASE;
  void* args[] = {&p};
  hipError_t e = hipLaunchCooperativeKernel((void*)hybrid_fwd, dim3(grid_blocks), dim3(512), args, LDS_BYTES, stream);
  if (e != hipSuccess) fprintf(stderr, "cooperative launch failed: %s (grid %d)\n", hipGetErrorString(e), grid_blocks);
}
```

```cpp
#include <hip/hip_runtime.h>
#include <hip/hip_cooperative_groups.h>
#include <cstdio>
namespace cg = cooperative_groups;
__device__ __forceinline__ int TIDX() { int v = threadIdx.x; asm volatile("" : "+v"(v)); return v; }
__device__ __forceinline__ int BIDX() { int v = blockIdx.x; asm volatile("" : "+s"(v)); return v; }

#define XB_TMO      128
#define XB_XCNT(j)  (256  + 64 * (j))
#define XB_XSUB(j)  (1280 + 64 * (j))
#define XB_XGEN(j)  (2304 + 64 * (j))
#define XB_TOP      3328
#define XB_TOPGEN   3392
#define XCD_BAR_WORDS 3456
#define XB_SPIN_CAP (1u << 20)
#define XLAS __attribute__((address_space(3)))
__device__ __forceinline__ unsigned xb_ld(unsigned* p)              { return __hip_atomic_load(p, __ATOMIC_RELAXED, __HIP_MEMORY_SCOPE_AGENT); }
__device__ __forceinline__ unsigned xb_add(unsigned* p, unsigned v) { return __hip_atomic_fetch_add(p, v, __ATOMIC_RELAXED, __HIP_MEMORY_SCOPE_AGENT); }
__device__ __forceinline__ unsigned xb_xcc_id() { return (unsigned)__builtin_amdgcn_s_getreg((3 << 11) | 20) & 0xFu; }
#define XB_SPIN(cond, bar) do { unsigned _sp = 0; while (cond) { __builtin_amdgcn_s_sleep(1); \
    if ((++_sp & 255u) == 0u) { if (xb_ld(&(bar)[XB_TMO])) break; if (_sp > XB_SPIN_CAP) { atomicAdd(&(bar)[XB_TMO], 1u); break; } } } } while (0)
struct XcdBarrier { unsigned* bar; unsigned x; volatile XLAS unsigned* st; };
__device__ __forceinline__ XcdBarrier xcd_barrier_post(unsigned* bar, volatile XLAS unsigned* st) {
    XcdBarrier b; b.bar = bar; b.x = xb_xcc_id(); b.st = st;
    if (threadIdx.x == 0) (void)xb_add(&bar[XB_XCNT(b.x)], 1u);
    return b;
}
__device__ __forceinline__ void xcd_barrier_complete(unsigned* bar, unsigned x, unsigned& nloc, unsigned& nx) {
    const unsigned G = gridDim.x * gridDim.y * gridDim.z;
    unsigned sum, cnt, mine, sp = 0u;
    for (;;) {
        sum = 0u; cnt = 0u; mine = 0u;
#pragma unroll
        for (unsigned j = 0; j < 16; ++j) { const unsigned c = xb_ld(&bar[XB_XCNT(j)]); sum += c; cnt += (c > 0u) ? 1u : 0u; mine = (j == x) ? c : mine; }
        if (sum == G) break;
        __builtin_amdgcn_s_sleep(1);
        if ((++sp & 255u) == 0u) { if (xb_ld(&bar[XB_TMO])) break; if (sp > XB_SPIN_CAP) { atomicAdd(&bar[XB_TMO], 1u); break; } }
    }
    nloc = mine > 0u ? mine : 1u; nx = cnt > 0u ? cnt : 1u;
}
__device__ __forceinline__ void xcd_barrier(const XcdBarrier& b) {
    asm volatile("s_waitcnt vmcnt(0)" ::: "memory");
    __syncthreads();
    if (threadIdx.x == 0) {
        unsigned* bar = b.bar;
        __builtin_amdgcn_s_waitcnt(0);
        unsigned nloc = b.st[0], nx = b.st[1];
        if (nloc == 0u) { xcd_barrier_complete(bar, b.x, nloc, nx); b.st[0] = nloc; b.st[1] = nx; }
        const unsigned old = xb_add(&bar[XB_XSUB(b.x)], 1u);
        const unsigned gen = old / nloc;
        if (old + 1u == (gen + 1u) * nloc) {
            __builtin_amdgcn_fence(__ATOMIC_RELEASE, "agent");
            asm volatile("s_waitcnt vmcnt(0)" ::: "memory");
            const unsigned og = xb_add(&bar[XB_TOP], 1u);
            const unsigned tg = og / nx;
            if (og + 1u == (tg + 1u) * nx) xb_add(&bar[XB_TOPGEN], 1u);
            else XB_SPIN(xb_ld(&bar[XB_TOPGEN]) == tg, bar);
            __builtin_amdgcn_fence(__ATOMIC_ACQUIRE, "agent");
            xb_add(&bar[XB_XGEN(b.x)], 1u);
            asm volatile("s_waitcnt vmcnt(0)" ::: "memory");
        } else {
            XB_SPIN(xb_ld(&bar[XB_XGEN(b.x)]) == gen, bar);
            __builtin_amdgcn_fence(__ATOMIC_ACQUIRE, "agent");
            asm volatile("s_waitcnt vmcnt(0)" ::: "memory");
        }
    }
    __syncthreads();
}
namespace pg8 {
#define PG8_LAS __attribute__((address_space(3)))
typedef unsigned short bf16_t;
typedef short bf16x8 __attribute__((ext_vector_type(8)));
typedef float f32x4 __attribute__((ext_vector_type(4)));
typedef unsigned u32x4 __attribute__((ext_vector_type(4)));
constexpr int BM = 256, BK = 64, HALF = 128, HTB = HALF * BK * 2  , STAGE_BYTES = 8 * HTB, NXCD = 8, WGM = 8;

__host__ __device__ __forceinline__ int lds_byte(int r, int c) { const int st = (r >> 4) * 2 + (c >> 5), rr = r & 15, cc = c & 31, ob = rr * 64 + cc * 2; return st * 1024 + (ob ^ (((ob >> 9) & 1) << 5)); }
__host__ __device__ __forceinline__ void stage_rc(int b, int& R, int& C) { const int st = b / 1024, sb = b % 1024, swz = sb ^ (((sb >> 9) & 1) << 5); R = (st >> 1) * 16 + swz / 64; C = (st & 1) * 32 + (swz % 64) / 2; }
__host__ __device__ __forceinline__ int perm32(int rho) { const int n = rho >> 4, i = rho & 15; return 8 * (i >> 2) + 4 * n + (i & 3); }

struct Unit { int pm, pn; };
struct Gemm { const bf16_t* A; const bf16_t* Bt; int M, N, K; };

struct StaticOrder {
    int nM, nN, nwg, G, c;
    __host__ __device__ void init(int M, int N, int G_, int c_) { nM = M / BM; nN = N / BM; nwg = nM * nN; G = G_; c = c_; }
    __host__ __device__ bool next(int i, Unit& u) const {
        const long L = (long)i * G + c; if (L >= nwg) return false;
        int wgid = (int)L; { const int q = nwg / NXCD, r = nwg % NXCD, xcd = wgid % NXCD, off = wgid / NXCD; wgid = (xcd < r ? xcd * (q + 1) : r * (q + 1) + (xcd - r) * q) + off; }
        const int nig = WGM * nN, gid = wgid / nig, fm = gid * WGM, gsz = (nM - fm) < WGM ? (nM - fm) : WGM;
        u.pm = fm + ((wgid % nig) % gsz); u.pn = (wgid % nig) / gsz; return true;
    }
    __device__ __forceinline__ void a_ready(const Unit&) const {}
    __device__ __forceinline__ void done(const Unit&) const {}
};
__device__ __forceinline__ unsigned cvt_pk_bf16(float lo, float hi) { unsigned r; asm volatile("v_cvt_pk_bf16_f32 %0, %1, %2" : "=v"(r) : "v"(lo), "v"(hi)); return r; }
template <class Epi, class Sched, bool STAMP = false>
__device__ __forceinline__ void gemm_phase(PG8_LAS unsigned char* lds, const Gemm g, const Sched& S, const Epi& E, unsigned long long* stamps) {
    const int tid = TIDX(), wid = __builtin_amdgcn_readfirstlane(tid >> 6), lane = tid & 63, wr = wid >> 2, wc = wid & 3, fr = lane & 15, fq = lane >> 4;
    const int K = g.K, nt = K / BK;
    int ts_lo = 0, ts_hi = 0, nts = 0; const unsigned long long rt_entry = STAMP ? (unsigned long long)wall_clock64() : 0ull;
#define PG8_STAMP() do { if (STAMP && wid == 0 && nts < 64) { const unsigned long long _c = (unsigned long long)clock64(); \
        ts_lo = (lane == nts) ? (int)(unsigned)_c : ts_lo; ts_hi = (lane == nts) ? (int)(unsigned)(_c >> 32) : ts_hi; ++nts; } } while (0)
    PG8_STAMP();
    unsigned voffA[2], voffB[2];
#pragma unroll
    for (int i = 0; i < 2; ++i) { int R, C; stage_rc(tid * 16 + i * 8192, R, C); const int Rb = Epi::PERM ? ((R & ~31) + perm32(R & 31)) : R;
        voffA[i] = (unsigned)(R * K + C) * 2u; voffB[i] = (unsigned)(Rb * K + C) * 2u; }
    const size_t kstep = (size_t)(BK * 2);
    const size_t hstep = (size_t)HALF * K * 2;
    const size_t tstep = 2 * hstep;
    const unsigned ldsw = (unsigned)wid * 1024u;
    const int aoff = lds_byte(wr * 64 + fr, fq * 8), boff = lds_byte(wc * 32 + fr, fq * 8);
#define PG8_SA(b, h) (((b) * 2 + (h)) * HTB)
#define PG8_SB(b, h) ((4 + (b) * 2 + (h)) * HTB)
#define PG8_STAGE(bufoff, gbase, voff) do { _Pragma("unroll") for (int _i = 0; _i < 2; ++_i) \
        __builtin_amdgcn_global_load_lds((const unsigned*)((const char*)(gbase) + (voff)[_i]), (PG8_LAS unsigned*)(lds + (bufoff) + ldsw + _i * 8192), 16, 0, 0); } while (0)
#define PG8_LDA(dst, b, h) do { _Pragma("unroll") for (int m = 0; m < 4; ++m) _Pragma("unroll") for (int k = 0; k < 2; ++k) dst[m][k] = *(const PG8_LAS bf16x8*)(lds + PG8_SA(b, h) + aoff + m * 2048 + k * 1024); } while (0)
#define PG8_LDB(dst, b, h) do { _Pragma("unroll") for (int n = 0; n < 2; ++n) _Pragma("unroll") for (int k = 0; k < 2; ++k) dst[n][k] = *(const PG8_LAS bf16x8*)(lds + PG8_SB(b, h) + boff + n * 2048 + k * 1024); } while (0)
#define PG8_MMA(ai, bj, At, Bt) do { __builtin_amdgcn_s_setprio(1); _Pragma("unroll") for (int m = 0; m < 4; ++m) _Pragma("unroll") for (int n = 0; n < 2; ++n) _Pragma("unroll") for (int k = 0; k < 2; ++k) \
        acc[ai][bj][m][n] = __builtin_amdgcn_mfma_f32_16x16x32_bf16(Bt[n][k], At[m][k], acc[ai][bj][m][n], 0, 0, 0); __builtin_amdgcn_s_setprio(0); } while (0)
#define PG8_WAIT_V(n) asm volatile("s_waitcnt vmcnt(" #n ")" ::: "memory")
#define PG8_WAIT_L(n) asm volatile("s_waitcnt lgkmcnt(" #n ")" ::: "memory")
#define PG8_BAR __builtin_amdgcn_s_barrier()
#define PG8_SCHED __builtin_amdgcn_sched_barrier(0)
    Unit cur, nxt; int ui = 0;
    if (!S.next(0, cur)) return;
    f32x4 acc[2][2][4][2];
#pragma unroll
    for (int a = 0; a < 2; ++a)
#pragma unroll
        for (int b = 0; b < 2; ++b)
#pragma unroll
            for (int m = 0; m < 4; ++m)
#pragma unroll
                for (int n = 0; n < 2; ++n) acc[a][b][m][n] = (f32x4){0.f, 0.f, 0.f, 0.f};
    bf16x8 At[4][2], B0[2][2], B1[2][2];
    const char* cA = (const char*)g.A + (size_t)cur.pm * tstep; const char* cB = (const char*)g.Bt + (size_t)cur.pn * tstep;
    S.a_ready(cur);
    PG8_STAGE(PG8_SB(0, 0), cB, voffB); PG8_STAGE(PG8_SA(0, 0), cA, voffA); PG8_STAGE(PG8_SB(0, 1), cB + hstep, voffB); PG8_STAGE(PG8_SA(0, 1), cA + hstep, voffA);
    if (wr == 1) PG8_BAR;
    PG8_WAIT_V(4); PG8_BAR;
    PG8_STAGE(PG8_SB(1, 0), cB + kstep, voffB); PG8_STAGE(PG8_SA(1, 0), cA + kstep, voffA); PG8_STAGE(PG8_SB(1, 1), cB + hstep + kstep, voffB);
    PG8_WAIT_V(6); PG8_BAR;
    PG8_STAMP();
    for (;;) {
        const bool has_next = S.next(ui + 1, nxt);
        const char* nA = has_next ? (const char*)g.A + (size_t)nxt.pm * tstep : cA; const char* nB = has_next ? (const char*)g.Bt + (size_t)nxt.pn * tstep : cB;
        for (int t = 0; t < nt; t += 2) {
            const bool last = (t == nt - 2);
            const char* a1 = cA + (size_t)(t + 1) * kstep;
            const char* a2 = last ? nA : cA + (size_t)(t + 2) * kstep; const char* b2 = last ? nB : cB + (size_t)(t + 2) * kstep;
            const char* a3 = a2 + kstep; const char* b3 = b2 + kstep;
            if (last && has_next) S.a_ready(nxt);
            if constexpr (Epi::MID_T >= 0) { if (t == Epi::MID_T) { PG8_SCHED; E.mid(acc, cur, wr, wc, fr, fq); PG8_SCHED; } }
            PG8_LDB(B0, 0, 0); PG8_SCHED; PG8_LDA(At, 0, 0); PG8_STAGE(PG8_SA(1, 1), a1 + hstep, voffA);
            PG8_WAIT_L(8); PG8_BAR; PG8_WAIT_L(0); PG8_MMA(0, 0, At, B0); PG8_BAR; PG8_SCHED;
            PG8_LDB(B1, 0, 1); PG8_STAGE(PG8_SB(0, 0), b2, voffB);
            PG8_BAR; PG8_WAIT_L(0); PG8_MMA(0, 1, At, B1); PG8_BAR;
            PG8_LDA(At, 0, 1); PG8_STAGE(PG8_SA(0, 0), a2, voffA);
            PG8_BAR; PG8_WAIT_L(0); PG8_MMA(1, 0, At, B0); PG8_BAR; PG8_SCHED;
            PG8_STAGE(PG8_SB(0, 1), b2 + hstep, voffB);
            PG8_WAIT_V(6); PG8_BAR; PG8_MMA(1, 1, At, B1); PG8_BAR;
            PG8_LDB(B0, 1, 0); PG8_SCHED; PG8_LDA(At, 1, 0); PG8_STAGE(PG8_SA(0, 1), a2 + hstep, voffA);
            PG8_WAIT_L(8); PG8_BAR; PG8_WAIT_L(0); PG8_MMA(0, 0, At, B0); PG8_BAR; PG8_SCHED;
            PG8_LDB(B1, 1, 1); PG8_STAGE(PG8_SB(1, 0), b3, voffB);
            PG8_BAR; PG8_WAIT_L(0); PG8_MMA(0, 1, At, B1); PG8_BAR;
            PG8_LDA(At, 1, 1); PG8_STAGE(PG8_SA(1, 0), a3, voffA);
            PG8_BAR; PG8_WAIT_L(0); PG8_MMA(1, 0, At, B0); PG8_BAR; PG8_SCHED;
            PG8_STAGE(PG8_SB(1, 1), b3 + hstep, voffB);
            PG8_WAIT_V(6); PG8_BAR; PG8_MMA(1, 1, At, B1); PG8_BAR;
        }
        PG8_STAMP();
        if constexpr (!Epi::AFTER_DRAIN) { E(acc, cur, wr, wc, fr, fq); S.done(cur); }
        PG8_STAMP();
        if (!has_next) break;
#pragma unroll
        for (int a = 0; a < 2; ++a)
#pragma unroll
            for (int b = 0; b < 2; ++b)
#pragma unroll
                for (int m = 0; m < 4; ++m)
#pragma unroll
                    for (int n = 0; n < 2; ++n) acc[a][b][m][n] = (f32x4){0.f, 0.f, 0.f, 0.f};
        cur = nxt; cA = nA; cB = nB; ++ui;
    }
    PG8_WAIT_V(0);
    if (wr == 0) PG8_BAR;
    PG8_BAR;
    if constexpr (Epi::AFTER_DRAIN) { E.fused(acc, cur, wr, wc, fr, fq, lds, wid, lane); S.done(cur); }
    PG8_STAMP();
    if (STAMP && wid == 0) { stamps[lane] = lane < nts ? (((unsigned long long)(unsigned)ts_hi << 32) | (unsigned)ts_lo) : 0ull;
        if (lane == 62) stamps[62] = rt_entry; if (lane == 63) stamps[63] = (unsigned long long)wall_clock64(); }
#undef PG8_STAMP
#undef PG8_SA
#undef PG8_SB
#undef PG8_STAGE
#undef PG8_LDA
#undef PG8_LDB
#undef PG8_MMA
#undef PG8_WAIT_V
#undef PG8_WAIT_L
#undef PG8_BAR
#undef PG8_SCHED
}
}

using pg8::bf16_t; using pg8::bf16x8; using pg8::f32x4; using pg8::u32x4;
#define LAS __attribute__((address_space(3)))
typedef short v4i16_t __attribute__((ext_vector_type(4)));
typedef unsigned u32x2 __attribute__((ext_vector_type(2)));

constexpr int DM = 1024, SEQ = 8192, MTOK = 16384;
constexpr size_t MiB = 1048576;
constexpr size_t SM_LAYER = 5 * MiB + 256 * 1024;
constexpr size_t OFF_WCAT = 0, OFF_WO = 3 * MiB, OFF_WRG = 5 * MiB, OFF_WIG = 5 * MiB + 128 * 1024;
constexpr size_t WS_MOD = 2 * SM_LAYER;
constexpr size_t WS_AGG = WS_MOD + 65536;
constexpr size_t WS_WIN = 12 * MiB;
constexpr size_t WS_H = 30 * MiB;
constexpr size_t WS_R = 62 * MiB;
constexpr size_t WS_GATT = 206 * MiB;
constexpr size_t WS_ACAT = 222 * MiB;
constexpr size_t WS_ML = 270 * MiB;
constexpr size_t WS_BAR = WS_ML + 2 * MiB;
constexpr size_t WS_FLAG = WS_BAR + 16384;
constexpr size_t WS_END = WS_BAR + 32768;
constexpr int LDS_MAIN = 147968, LDS_BYTES = LDS_MAIN + 16;
constexpr int NPHASE = 16;

struct Params {
  const float *x, *c, *w_mod, *b_mod, *g_pre, *w_in, *conv_w, *conv_b, *w_rg, *b_rg, *w_ig, *b_ig, *lam, *w_pa, *w_pb, *w_o, *g_post;
  float* out; unsigned char* ws; int ph_lo, ph_hi;
};

__device__ __forceinline__ float bflo(unsigned w) { return __uint_as_float(w << 16); }
__device__ __forceinline__ float bfhi(unsigned w) { return __uint_as_float(w & 0xffff0000u); }
__device__ __forceinline__ unsigned pk2(float lo, float hi) { return pg8::cvt_pk_bf16(lo, hi); }
__device__ __forceinline__ float shfl_xor_f(float v, int mask, int lane) { return __int_as_float(__builtin_amdgcn_ds_bpermute((lane ^ mask) << 2, __float_as_int(v))); }
__device__ __forceinline__ float shfl_idx_f(float v, int src) { return __int_as_float(__builtin_amdgcn_ds_bpermute(src << 2, __float_as_int(v))); }
__device__ __forceinline__ float dpp_add(float v, int ctrl_sel) {
  int r;
  if (ctrl_sel == 0) r = __builtin_amdgcn_update_dpp(0, __float_as_int(v), 0xB1, 0xF, 0xF, true);
  else if (ctrl_sel == 1) r = __builtin_amdgcn_update_dpp(0, __float_as_int(v), 0x4E, 0xF, 0xF, true);
  else if (ctrl_sel == 2) r = __builtin_amdgcn_update_dpp(0, __float_as_int(v), 0x141, 0xF, 0xF, true);
  else r = __builtin_amdgcn_update_dpp(0, __float_as_int(v), 0x140, 0xF, 0xF, true);
  return v + __int_as_float(r);
}
__device__ __forceinline__ float wave_sum(float v, int lane) {
  v = dpp_add(v, 0); v = dpp_add(v, 1); v = dpp_add(v, 2); v = dpp_add(v, 3);
  v += shfl_xor_f(v, 16, lane); v += shfl_xor_f(v, 32, lane); return v; }
__device__ __forceinline__ void wave_fence() { asm volatile("s_waitcnt lgkmcnt(0)" ::: "memory"); __builtin_amdgcn_wave_barrier(); }
__device__ __forceinline__ void st16_wt(void* p, u32x4 v) { asm volatile("global_store_dwordx4 %0, %1, off sc1\n\ts_nop 1" :: "v"(p), "v"(v) : "memory"); }
#define NTL(p) __builtin_nontemporal_load(p)
__device__ __forceinline__ void lds_barrier() { asm volatile("s_waitcnt lgkmcnt(0)" ::: "memory"); __builtin_amdgcn_s_barrier(); asm volatile("" ::: "memory"); }
__device__ __forceinline__ float sigmoidf_(float v) { return __builtin_amdgcn_rcpf(1.f + __expf(-v)); }

__device__ __forceinline__ void transpose_tile(const float* __restrict__ src, int N, bf16_t* __restrict__ dst, int ldd, int koff, int k0, int n0, float* tl, float scale = 1.0f) {
  const int tid = TIDX(), c = tid & 63, r = tid >> 6;
#pragma unroll
  for (int i = 0; i < 8; ++i) { const int k = r + 8 * i; tl[k * 65 + c] = NTL(src + (size_t)(k0 + k) * N + n0 + c) * scale; }
  lds_barrier();
  const int n = tid >> 3, kb = (tid & 7) * 8;
  u32x4 w;
  w.x = pk2(tl[(kb + 0) * 65 + n], tl[(kb + 1) * 65 + n]); w.y = pk2(tl[(kb + 2) * 65 + n], tl[(kb + 3) * 65 + n]);
  w.z = pk2(tl[(kb + 4) * 65 + n], tl[(kb + 5) * 65 + n]); w.w = pk2(tl[(kb + 6) * 65 + n], tl[(kb + 7) * 65 + n]);
  *(u32x4*)(dst + (size_t)(n0 + n) * ldd + koff + k0 + kb) = w;
  lds_barrier();
}
__device__ __forceinline__ void transpose_wide(const float* __restrict__ src, int N, bf16_t* __restrict__ dst, int ldd, int koff, int k0, int n0, float* tl) {
  const int tid = TIDX(), c4 = (tid & 63) * 4, r = tid >> 6;
  float4 v[8];
#pragma unroll
  for (int i = 0; i < 8; ++i) { const f32x4 q_ = NTL((const f32x4*)(src + (size_t)(k0 + r + 8 * i) * N + n0 + c4)); v[i] = make_float4(q_[0], q_[1], q_[2], q_[3]); }
#pragma unroll
  for (int i = 0; i < 8; ++i) *(float4*)(tl + (r + 8 * i) * 260 + c4) = v[i];
  lds_barrier();
  const int n = tid >> 1, kb = (tid & 1) * 32;
#pragma unroll
  for (int q = 0; q < 4; ++q) { const int kq = kb + q * 8; u32x4 w;
    w.x = pk2(tl[(kq + 0) * 260 + n], tl[(kq + 1) * 260 + n]); w.y = pk2(tl[(kq + 2) * 260 + n], tl[(kq + 3) * 260 + n]);
    w.z = pk2(tl[(kq + 4) * 260 + n], tl[(kq + 5) * 260 + n]); w.w = pk2(tl[(kq + 6) * 260 + n], tl[(kq + 7) * 260 + n]);
    *(u32x4*)(dst + (size_t)(n0 + n) * ldd + koff + k0 + kq) = w; }
  lds_barrier();
}
__device__ __forceinline__ void convert_win(const Params& p, int l, int item, float* tl) {
  transpose_wide(p.w_in + (size_t)l * 1024 * 9216, 9216, (bf16_t*)(p.ws + WS_WIN), 1024, 0, (item / 36) * 64, (item % 36) * 256, tl);
}
__device__ __forceinline__ void convert_small(const Params& p, int l, int item, float* tl) {
  unsigned char* base = p.ws + (size_t)l * SM_LAYER;
  if (item < 32) { transpose_wide(p.w_pa + (size_t)l * 512 * 1024, 1024, (bf16_t*)(base + OFF_WCAT), 1536, 0, (item >> 2) * 64, (item & 3) * 256, tl); }
  else if (item < 96) { const int it = item - 32; transpose_wide(p.w_pb + (size_t)l * 1024 * 1024, 1024, (bf16_t*)(base + OFF_WCAT), 1536, 512, (it >> 2) * 64, (it & 3) * 256, tl); }
  else if (item < 160) { const int it = item - 96; transpose_wide(p.w_o + (size_t)l * 1024 * 1024, 1024, (bf16_t*)(base + OFF_WO), 1024, 0, (it >> 2) * 64, (it & 3) * 256, tl); }
  else if (item < 176) { const int h = item - 160; transpose_tile(p.w_rg + (size_t)l * 65536 + h * 4096, 64, (bf16_t*)(base + OFF_WRG) + h * 4096, 64, 0, 0, 0, tl, -1.4426950408889634f); }
  else { const int h = item - 176; transpose_tile(p.w_ig + (size_t)l * 65536 + h * 4096, 64, (bf16_t*)(base + OFF_WIG) + h * 4096, 64, 0, 0, 0, tl, -1.4426950408889634f); }
}
__device__ __forceinline__ void mod_item(const Params& p, int l, int cgp, float* red) {
  const int tid = TIDX(), w = tid >> 6, lane = tid & 63;
  const float* W = p.w_mod + (size_t)l * 1024 * 3072;
  float* mod = (float*)(p.ws + WS_MOD);
  const int col = cgp * 64 + lane;
  float* sl = red + 1024;
#pragma unroll
  for (int q = 0; q < 4; ++q) { const float cv = p.c[tid + 512 * q]; sl[tid + 512 * q] = cv * sigmoidf_(cv); }
  __syncthreads();
  float a0 = 0.f, a1 = 0.f;
  for (int k0 = w * 128; k0 < w * 128 + 128; k0 += 16) {
    float wv[16];
#pragma unroll
    for (int e = 0; e < 16; ++e) wv[e] = NTL(W + (size_t)(k0 + e) * 3072 + col);
#pragma unroll
    for (int e = 0; e < 16; ++e) { a0 += sl[k0 + e] * wv[e]; a1 += sl[1024 + k0 + e] * wv[e]; }
  }
  red[(w * 2 + 0) * 64 + lane] = a0; red[(w * 2 + 1) * 64 + lane] = a1;
  __syncthreads();
  if (tid < 128) { const int b = tid >> 6; float s = 0.f;
#pragma unroll
    for (int ww = 0; ww < 8; ++ww) s += red[(ww * 2 + b) * 64 + lane];
    mod[(l * 2 + b) * 3072 + col] = s + p.b_mod[l * 3072 + col]; }
  __syncthreads();
}
__device__ __forceinline__ void prologue_phase(const Params& p, unsigned char* smem) {
  float* tl = (float*)smem;
  for (int it = BIDX(); it < 96 + 2 * 192 + 576; it += gridDim.x) {
    if (it < 576) convert_win(p, 0, it, tl);
    else if (it < 576 + 96) { const int j = it - 576; mod_item(p, j / 48, j % 48, tl); }
    else { const int j = it - 576 - 96; convert_small(p, j / 192, j % 192, tl); }
  }
}

__device__ __forceinline__ void prenorm_phase(const Params& p, const float* xsrc, int l) {
  const int lane = TIDX() & 63, nw = gridDim.x * 8;
  const float* gp = p.g_pre + l * 1024; const float* md = (const float*)(p.ws + WS_MOD) + l * 2 * 3072;
  bf16_t* h = (bf16_t*)(p.ws + WS_H);
  float4 gm[4], gs[4]; int bcur = -1;
  for (int row0 = (BIDX() * 8 + (TIDX() >> 6)) * 2; row0 < MTOK; row0 += nw * 2) {
    { const int b = row0 >> 13;
      if (b != bcur) { bcur = b;
#pragma unroll
        for (int i = 0; i < 4; ++i) { const int col = (lane + 64 * i) * 4;
          const float4 g = *(const float4*)(gp + col), sh = *(const float4*)(md + b * 3072 + col), sc = *(const float4*)(md + b * 3072 + 1024 + col);
          gm[i] = make_float4(g.x * (1.f + sc.x), g.y * (1.f + sc.y), g.z * (1.f + sc.z), g.w * (1.f + sc.w)); gs[i] = sh; } } }
    float4 v[2][4];
#pragma unroll
    for (int r = 0; r < 2; ++r) { const float4* xr = (const float4*)(xsrc + (size_t)(row0 + r) * 1024);
#pragma unroll
      for (int i = 0; i < 4; ++i) { const f32x4 q_ = NTL((const f32x4*)(xr + lane + 64 * i)); v[r][i] = make_float4(q_[0], q_[1], q_[2], q_[3]); } }
#pragma unroll
    for (int r = 0; r < 2; ++r) { const int row = row0 + r; float ss = 0.f;
#pragma unroll
      for (int i = 0; i < 4; ++i) ss += v[r][i].x * v[r][i].x + v[r][i].y * v[r][i].y + v[r][i].z * v[r][i].z + v[r][i].w * v[r][i].w;
      ss = wave_sum(ss, lane);
      const float rstd = rsqrtf(ss * (1.f / 1024.f) + 1e-6f);
#pragma unroll
      for (int i = 0; i < 4; ++i) { const int col = (lane + 64 * i) * 4; const float4 g = gm[i], sh = gs[i];
        u32x2 w; w.x = pk2(v[r][i].x * rstd * g.x + sh.x, v[r][i].y * rstd * g.y + sh.y);
        w.y = pk2(v[r][i].z * rstd * g.z + sh.z, v[r][i].w * rstd * g.w + sh.w);
        *(u32x2*)(h + (size_t)row * 1024 + col) = w; } }
  }
}

__device__ __forceinline__ float actf(float v, int act, float sc) { if (act == 0) return v * sc; const float r = sigmoidf_(v); return act == 1 ? v * r : r; }
template <int MODE> struct EpiT {
  static constexpr bool PERM = true, AFTER_DRAIN = false; static constexpr int MID_T = -1;
  unsigned char* ws;
  __device__ __forceinline__ void operator()(const f32x4 (&acc)[2][2][4][2], const pg8::Unit& u, int wr, int wc, int fr, int fq) const {
    bf16_t* dst; int ldc, pn0, act; float sc = 1.0f;
    if (MODE == 0) { if (u.pn < 18) { dst = (bf16_t*)(ws + WS_R); ldc = 4608; pn0 = 0; act = 0; if (u.pn < 6) sc = 0.08838834764831845f * 1.4426950408889634f; }
                     else { dst = (bf16_t*)(ws + WS_GATT); ldc = 512; pn0 = 18; act = 1; } }
    else if (MODE == 1) { if (u.pn < 4) { dst = (bf16_t*)(ws + WS_R); ldc = 1024; pn0 = 0; act = 0; }
                          else if (u.pn < 8) { dst = (bf16_t*)(ws + WS_R + 32 * MiB); ldc = 1024; pn0 = 4; act = 1; }
                          else { dst = (bf16_t*)(ws + WS_R + 64 * MiB); ldc = 2048; pn0 = 8; act = 2; } }
    else { dst = (bf16_t*)(ws + WS_R); ldc = 1024; pn0 = 0; act = 0; }
    asm volatile("" : "+v"(fr), "+v"(fq));
    const int row0 = u.pm * 256 + wr * 64 + fr, col0 = (u.pn - pn0) * 256 + wc * 32 + 8 * fq;
#pragma unroll
    for (int ai = 0; ai < 2; ++ai)
#pragma unroll
      for (int m = 0; m < 4; ++m) { bf16_t* rowp = dst + (size_t)(row0 + ai * 128 + m * 16) * ldc + col0;
#pragma unroll
        for (int bj = 0; bj < 2; ++bj) { const f32x4 v0 = acc[ai][bj][m][0], v1 = acc[ai][bj][m][1];
          u32x4 w; w.x = pk2(actf(v0[0], act, sc), actf(v0[1], act, sc)); w.y = pk2(actf(v0[2], act, sc), actf(v0[3], act, sc));
          w.z = pk2(actf(v1[0], act, sc), actf(v1[1], act, sc)); w.w = pk2(actf(v1[2], act, sc), actf(v1[3], act, sc));
          st16_wt(rowp + bj * 128, w); } }
  }
  __device__ __forceinline__ void mid(f32x4 (&)[2][2][4][2], const pg8::Unit&, int, int, int, int) const {}
};
struct EpiZ {
  static constexpr bool PERM = true, AFTER_DRAIN = false; static constexpr int MID_T = 8;
  const bf16_t* mg; bf16_t* z;
  __device__ __forceinline__ void mid(f32x4 (&acc)[2][2][4][2], const pg8::Unit& u, int wr, int wc, int fr, int fq) const {
    asm volatile("" : "+v"(fr), "+v"(fq));
    const int row0 = u.pm * 256 + wr * 64 + fr, col0 = u.pn * 256 + wc * 32 + 8 * fq;
#pragma unroll
    for (int ai = 0; ai < 2; ++ai)
#pragma unroll
      for (int mp = 0; mp < 2; ++mp) {
        u32x4 ga[2][2], gb[2][2];
#pragma unroll
        for (int mm = 0; mm < 2; ++mm) { const bf16_t* rp = mg + (size_t)(row0 + ai * 128 + (2 * mp + mm) * 16) * 2048 + col0;
#pragma unroll
          for (int bj = 0; bj < 2; ++bj) { ga[mm][bj] = NTL((const u32x4*)(rp + bj * 128)); gb[mm][bj] = NTL((const u32x4*)(rp + 1024 + bj * 128)); } }
#pragma unroll
        for (int mm = 0; mm < 2; ++mm)
#pragma unroll
          for (int bj = 0; bj < 2; ++bj) { const u32x4 a_ = ga[mm][bj], b_ = gb[mm][bj]; const int m = 2 * mp + mm;
            f32x4 r0, r1;
            r0[0] = bflo(a_.x) * __builtin_amdgcn_rcpf(bflo(b_.x)); r0[1] = bfhi(a_.x) * __builtin_amdgcn_rcpf(bfhi(b_.x));
            r0[2] = bflo(a_.y) * __builtin_amdgcn_rcpf(bflo(b_.y)); r0[3] = bfhi(a_.y) * __builtin_amdgcn_rcpf(bfhi(b_.y));
            r1[0] = bflo(a_.z) * __builtin_amdgcn_rcpf(bflo(b_.z)); r1[1] = bfhi(a_.z) * __builtin_amdgcn_rcpf(bfhi(b_.z));
            r1[2] = bflo(a_.w) * __builtin_amdgcn_rcpf(bflo(b_.w)); r1[3] = bfhi(a_.w) * __builtin_amdgcn_rcpf(bfhi(b_.w));
            acc[ai][bj][m][0] *= r0; acc[ai][bj][m][1] *= r1; }
        asm volatile("" ::: "memory"); __builtin_amdgcn_sched_barrier(0); }
  }
  __device__ __forceinline__ void operator()(const f32x4 (&acc)[2][2][4][2], const pg8::Unit& u, int wr, int wc, int fr, int fq) const {
    asm volatile("" : "+v"(fr), "+v"(fq));
    const int row0 = u.pm * 256 + wr * 64 + fr, col0 = u.pn * 256 + wc * 32 + 8 * fq;
#pragma unroll
    for (int ai = 0; ai < 2; ++ai) {
      u32x4 gb[4][2];
#pragma unroll
      for (int m = 0; m < 4; ++m)
#pragma unroll
        for (int bj = 0; bj < 2; ++bj) gb[m][bj] = NTL((const u32x4*)(mg + (size_t)(row0 + ai * 128 + m * 16) * 2048 + 1024 + col0 + bj * 128));
#pragma unroll
      for (int m = 0; m < 4; ++m) { const size_t ro = (size_t)(row0 + ai * 128 + m * 16);
#pragma unroll
        for (int bj = 0; bj < 2; ++bj) { const u32x4 g_ = gb[m][bj];
          const f32x4 v0 = acc[ai][bj][m][0], v1 = acc[ai][bj][m][1];
          u32x4 w; w.x = pk2(v0[0] * bflo(g_.x), v0[1] * bfhi(g_.x)); w.y = pk2(v0[2] * bflo(g_.y), v0[3] * bfhi(g_.y));
          w.z = pk2(v1[0] * bflo(g_.z), v1[1] * bfhi(g_.z)); w.w = pk2(v1[2] * bflo(g_.w), v1[3] * bfhi(g_.w));
          *(u32x4*)(z + ro * 1024 + col0 + bj * 128) = w; } }
      asm volatile("" ::: "memory"); }
  }
};

struct AttnItem { int g, hh, dil, n; size_t tokbase; };
__device__ __forceinline__ AttnItem attn_decode(int item) {
  AttnItem a; const int blk = item & 63, bg = item >> 8; a.hh = (item >> 6) & 3; a.g = bg % 3; const int b = bg / 3;
  const int dsh = 2 * a.g, nb = 64 >> dsh; a.dil = 1 << dsh; const int r = blk / nb; a.n = blk % nb; a.tokbase = (size_t)b * SEQ + r; return a;
}
__device__ __forceinline__ void attn_load(const bf16_t* qkv, const AttnItem& a, int tid, int w, int l15, int g4, u32x4 (&kr)[8], u32x4 (&vr)[8], bf16x8 (&qf)[4]) {
  const bf16_t* qp = qkv + a.g * 512 + a.hh * 128; const bf16_t* kp = qp + 1536; const bf16_t* vp = qp + 3072;
  const size_t tq = a.tokbase + (size_t)a.dil * (a.n * 128 + 16 * w + l15);
#pragma unroll
  for (int kk = 0; kk < 4; ++kk) qf[kk] = NTL((const bf16x8*)(qp + tq * 4608 + 32 * kk + 8 * g4));
  const bool odd = a.n & 1;
#pragma unroll
  for (int it = 0; it < 8; ++it) { if (odd && it >= 4) break;
    const int cid = it * 512 + tid, row = cid >> 4, ch = cid & 15;
    int idx = (odd ? a.n : a.n - 1) * 128 + row; if (idx < 0) idx = 0;
    const size_t tk = a.tokbase + (size_t)a.dil * idx;
    kr[it] = *(const u32x4*)(kp + tk * 4608 + ch * 8); vr[it] = *(const u32x4*)(vp + tk * 4608 + ch * 8); }
}
__device__ __forceinline__ void attn_phase(const Params& p, unsigned char* smem) {
  LAS unsigned char* lds = (LAS unsigned char*)smem;
  const int tid = TIDX(), lane = tid & 63, w = tid >> 6, g4 = lane >> 4, l15 = lane & 15;
  constexpr int KSTR = 272, VOFF = 256 * 272, VSTR = 288;
  for (int i = tid; i < 16 * VSTR / 4; i += 512) ((LAS unsigned*)(lds + VOFF + 256 * VSTR))[i] = 0u;
  const bf16_t* qkv = (const bf16_t*)(p.ws + WS_R);
  bf16_t* acat = (bf16_t*)(p.ws + WS_ACAT);
  float* mbuf = (float*)(p.ws + WS_ML); float* lbuf = mbuf + 3 * MTOK * 4;
  const int G = gridDim.x;
  int vb = BIDX();
  if (G == 256) vb = (vb & 7) * 32 + (vb >> 3);
  const int nsteps = (vb < 768) ? 2 * ((768 - vb + G - 1) / G) : 0;
  u32x4 kr[8], vr[8]; bf16x8 qn[4];
  u32x2 opk[8]; bf16_t* op_pend = acat; size_t ml_pend = 0; float mx_pend = 0.f, l_pend = 0.f;
  if (nsteps > 0) { const AttnItem a0 = attn_decode(2 * vb); attn_load(qkv, a0, tid, w, l15, g4, kr, vr, qn); }
  for (int s = 0; s < nsteps; ++s) {
    const int item = 2 * (vb + (s >> 1) * G) + (s & 1);
    const AttnItem a = attn_decode(item);
    const int g = a.g, hh = a.hh, dil = a.dil, n = a.n; const size_t tokbase = a.tokbase;
    const int rot = (s & 1) ? 128 : 0;
    lds_barrier();
#pragma unroll
    for (int it = 0; it < 8; ++it) { if ((s & 1) && it >= 4) break;
      const int cid = it * 512 + tid, row = cid >> 4, ch = cid & 15;
      *(LAS u32x4*)(lds + row * KSTR + ch * 16) = kr[it]; *(LAS u32x4*)(lds + VOFF + row * VSTR + ch * 16) = vr[it]; }
    bf16x8 qf[4];
#pragma unroll
    for (int kk = 0; kk < 4; ++kk) qf[kk] = qn[kk];
    lds_barrier();
    if (s > 0) {
#pragma unroll
      for (int dt = 0; dt < 8; ++dt) *(u32x2*)(op_pend + 16 * dt) = opk[dt];
      if (g4 == 0) { mbuf[ml_pend] = mx_pend; lbuf[ml_pend] = l_pend; } }
    if (s + 1 < nsteps) { const AttnItem an = attn_decode(2 * (vb + ((s + 1) >> 1) * G) + ((s + 1) & 1)); attn_load(qkv, an, tid, w, l15, g4, kr, vr, qn); }
    f32x4 S[9];
    { bf16x8 kc[4], kn[4];
#pragma unroll
      for (int kk = 0; kk < 4; ++kk) kc[kk] = *(const LAS bf16x8*)(lds + ((16 * w + l15) ^ rot) * KSTR + 64 * kk + 16 * g4);
#pragma unroll
      for (int T = 0; T < 9; ++T) {
        if (T < 8) {
#pragma unroll
          for (int kk = 0; kk < 4; ++kk) kn[kk] = *(const LAS bf16x8*)(lds + ((16 * (w + T + 1) + l15) ^ rot) * KSTR + 64 * kk + 16 * g4); }
        __builtin_amdgcn_sched_barrier(0);
        f32x4 a_ = {0.f, 0.f, 0.f, 0.f};
#pragma unroll
        for (int kk = 0; kk < 4; ++kk) a_ = __builtin_amdgcn_mfma_f32_16x16x32_bf16(kc[kk], qf[kk], a_, 0, 0, 0);
        S[T] = a_;
        __builtin_amdgcn_sched_barrier(0);
#pragma unroll
        for (int kk = 0; kk < 4; ++kk) kc[kk] = kn[kk]; } }
    float mx = -1e30f;
    if (n > 0) {
#pragma unroll
      for (int jj = 0; jj < 4; ++jj) { const int d0 = 4 * g4 + jj - l15; if (d0 < 0) S[0][jj] = -1e30f; if (d0 > 0) S[8][jj] = -1e30f; }
#pragma unroll
      for (int T = 0; T < 9; ++T)
#pragma unroll
        for (int jj = 0; jj < 4; ++jj) mx = fmaxf(mx, S[T][jj]);
    } else {
#pragma unroll
      for (int T = 0; T < 9; ++T)
#pragma unroll
        for (int jj = 0; jj < 4; ++jj) { const int dj = 16 * T + 4 * g4 + jj - l15, j = 16 * (w + T) + 4 * g4 + jj;
          const bool valid = (dj >= 0) && (dj <= 128) && (j >= 128);
          const float sv = valid ? S[T][jj] : -1e30f; S[T][jj] = sv; mx = fmaxf(mx, sv); }
    }
    mx = fmaxf(mx, shfl_xor_f(mx, 16, lane)); mx = fmaxf(mx, shfl_xor_f(mx, 32, lane));
    float lsum = 0.f;
#pragma unroll
    for (int T = 0; T < 9; ++T)
#pragma unroll
      for (int jj = 0; jj < 4; ++jj) { const float pv = __builtin_amdgcn_exp2f(S[T][jj] - mx); S[T][jj] = pv; lsum += pv; }
    lsum += shfl_xor_f(lsum, 16, lane); lsum += shfl_xor_f(lsum, 32, lane);
    f32x4 O[8];
#pragma unroll
    for (int dt = 0; dt < 8; ++dt) O[dt] = (f32x4){0.f, 0.f, 0.f, 0.f};
#pragma unroll
    for (int s5 = 0; s5 < 5; ++s5) { const int T0 = 2 * s5, T1 = 2 * s5 + 1;
      u32x4 pw; pw.x = pk2(S[T0][0], S[T0][1]); pw.y = pk2(S[T0][2], S[T0][3]);
      if (T1 < 9) { pw.z = pk2(S[T1 < 9 ? T1 : 0][0], S[T1 < 9 ? T1 : 0][1]); pw.w = pk2(S[T1 < 9 ? T1 : 0][2], S[T1 < 9 ? T1 : 0][3]); } else { pw.z = 0u; pw.w = 0u; }
      const bf16x8 pf = __builtin_bit_cast(bf16x8, pw);
      const int ra = (16 * (w + T0) + 4 * g4 + (l15 >> 2)) ^ rot;
      int rb = 16 * (w + T1) + 4 * g4 + (l15 >> 2); if (rb < 256) rb ^= rot;
      v4i16_t vA[8], vB[8];
#pragma unroll
      for (int dt = 0; dt < 8; ++dt) { const int cb = (16 * dt + 4 * (l15 & 3)) * 2;
        vA[dt] = __builtin_amdgcn_ds_read_tr16_b64_v4i16((LAS v4i16_t*)(lds + VOFF + ra * VSTR + cb));
        vB[dt] = __builtin_amdgcn_ds_read_tr16_b64_v4i16((LAS v4i16_t*)(lds + VOFF + rb * VSTR + cb)); }
      __builtin_amdgcn_sched_barrier(0);
#pragma unroll
      for (int dt = 0; dt < 8; ++dt) { const v4i16_t va = vA[dt], vb_ = vB[dt];
        bf16x8 vf; vf[0] = va[0]; vf[1] = va[1]; vf[2] = va[2]; vf[3] = va[3]; vf[4] = vb_[0]; vf[5] = vb_[1]; vf[6] = vb_[2]; vf[7] = vb_[3];
        O[dt] = __builtin_amdgcn_mfma_f32_16x16x32_bf16(vf, pf, O[dt], 0, 0, 0); }
      __builtin_amdgcn_sched_barrier(0); }
    { const float inv = 1.0f / lsum;
      const size_t t = tokbase + (size_t)dil * (n * 128 + 16 * w + l15);
      op_pend = acat + t * 1536 + g * 512 + hh * 128 + 4 * g4; ml_pend = ((size_t)g * MTOK + t) * 4 + hh; mx_pend = mx; l_pend = lsum;
#pragma unroll
      for (int dt = 0; dt < 8; ++dt) { opk[dt].x = pk2(O[dt][0] * inv, O[dt][1] * inv); opk[dt].y = pk2(O[dt][2] * inv, O[dt][3] * inv); } }
  }
  if (nsteps > 0) {
#pragma unroll
    for (int dt = 0; dt < 8; ++dt) *(u32x2*)(op_pend + 16 * dt) = opk[dt];
    if (g4 == 0) { mbuf[ml_pend] = mx_pend; lbuf[ml_pend] = l_pend; } }
}

__device__ __forceinline__ void mix_phase(const Params& p) {
  const int lane = TIDX() & 63, nw = gridDim.x * 8, c = lane * 8, j = lane >> 4;
  bf16_t* acat = (bf16_t*)(p.ws + WS_ACAT); const bf16_t* gatt = (const bf16_t*)(p.ws + WS_GATT);
  const float* mbuf = (const float*)(p.ws + WS_ML); const float* lbuf = mbuf + 3 * MTOK * 4;
  for (int t = BIDX() * 8 + (TIDX() >> 6); t < MTOK; t += nw) {
    const float m0 = mbuf[((size_t)0 * MTOK + t) * 4 + j], m1 = mbuf[((size_t)1 * MTOK + t) * 4 + j], m2 = mbuf[((size_t)2 * MTOK + t) * 4 + j];
    const float l0 = lbuf[((size_t)0 * MTOK + t) * 4 + j], l1 = lbuf[((size_t)1 * MTOK + t) * 4 + j], l2 = lbuf[((size_t)2 * MTOK + t) * 4 + j];
    const float mm = fmaxf(m0, fmaxf(m1, m2));
    float w0 = l0 * __builtin_amdgcn_exp2f(m0 - mm), w1 = l1 * __builtin_amdgcn_exp2f(m1 - mm), w2 = l2 * __builtin_amdgcn_exp2f(m2 - mm);
    const float inv = 1.0f / (w0 + w1 + w2); w0 *= inv; w1 *= inv; w2 *= inv;
    bf16_t* ap = acat + (size_t)t * 1536 + c;
    const u32x4 o0 = NTL((const u32x4*)ap), o1 = NTL((const u32x4*)(ap + 512)), o2 = NTL((const u32x4*)(ap + 1024)), ga = NTL((const u32x4*)(gatt + (size_t)t * 512 + c));
    u32x4 r;
    r.x = pk2((w0 * bflo(o0.x) + w1 * bflo(o1.x) + w2 * bflo(o2.x)) * bflo(ga.x), (w0 * bfhi(o0.x) + w1 * bfhi(o1.x) + w2 * bfhi(o2.x)) * bfhi(ga.x));
    r.y = pk2((w0 * bflo(o0.y) + w1 * bflo(o1.y) + w2 * bflo(o2.y)) * bflo(ga.y), (w0 * bfhi(o0.y) + w1 * bfhi(o1.y) + w2 * bfhi(o2.y)) * bfhi(ga.y));
    r.z = pk2((w0 * bflo(o0.z) + w1 * bflo(o1.z) + w2 * bflo(o2.z)) * bflo(ga.z), (w0 * bfhi(o0.z) + w1 * bfhi(o1.z) + w2 * bfhi(o2.z)) * bfhi(ga.z));
    r.w = pk2((w0 * bflo(o0.w) + w1 * bflo(o1.w) + w2 * bflo(o2.w)) * bflo(ga.w), (w0 * bfhi(o0.w) + w1 * bfhi(o1.w) + w2 * bfhi(o2.w)) * bfhi(ga.w));
    *(u32x4*)ap = r;
  }
}

__device__ __forceinline__ void lru_load_rows(const bf16_t* ub, size_t t0, int sbase, int tt, int chc, u32x4 (&ua)[4], u32x4 (&uv)[4]) {
#pragma unroll
  for (int j = 0; j < 4; ++j) { ua[j] = (u32x4){0u, 0u, 0u, 0u}; uv[j] = (u32x4){0u, 0u, 0u, 0u};
    if (sbase + tt - j >= 0) { const bf16_t* up = ub + (t0 + tt - j) * 1024 + chc; ua[j] = *(const u32x4*)up; uv[j] = *(const u32x4*)(up + 8); } }
}
__device__ __forceinline__ void lru_pass2(const Params& p, int l, unsigned char* smem, int vb) {
  const int tid = TIDX(), lane = tid & 63, w = tid >> 6;
  LAS float* Uc = (LAS float*)((LAS unsigned char*)smem + w * 4352);
  const unsigned* labuf = (const unsigned*)(p.ws + WS_H); const unsigned* xibuf = (const unsigned*)(p.ws + WS_R + 128 * MiB);
  const bf16_t* glru = (const bf16_t*)(p.ws + WS_R + 32 * MiB);
  bf16_t* acat = (bf16_t*)(p.ws + WS_ACAT);
  float* aggA = (float*)(p.ws + WS_AGG); float* aggH = aggA + 2 * 64 * 1024;
  const int tt = lane >> 2, c16 = (lane & 3) * 16;
  {
    const int hb = vb & 15, grp = vb >> 4, idx = grp * 8 + w, piece = idx & 63, b = idx >> 6;
    const int ch = hb * 64 + lane, chc = hb * 64 + c16;
    const unsigned* lap = labuf + (size_t)(idx * 16 + hb) * 4096 + lane; const unsigned* xip = xibuf + (size_t)(idx * 16 + hb) * 4096 + lane;
    unsigned lw[8], xw[8];
#pragma unroll
    for (int e = 0; e < 8; ++e) { lw[e] = NTL(lap + e * 64); xw[e] = NTL(xip + e * 64); }
    float hc = 0.f;
    {
      unsigned* flags = (unsigned*)(p.ws + WS_FLAG) + l * 256; const int g0 = 8 * b, nwait = grp - g0;
      unsigned spins = 0;
      for (;;) { const unsigned f = (lane < nwait) ? __hip_atomic_load(flags + hb + 16 * (g0 + lane), __ATOMIC_RELAXED, __HIP_MEMORY_SCOPE_AGENT) : 1u;
        if (__builtin_amdgcn_ballot_w64(f == 0u) == 0ull) break;
        if (++spins > (1u << 22)) break;
        __builtin_amdgcn_s_sleep(2); } }
    { float av[8], hv8[8];
#pragma unroll
      for (int e = 0; e < 8; ++e) { const bool ok = 8 * b + e < grp; const size_t o = (size_t)(ok ? 8 * b + e : grp) * 1024 + ch;
        const float a_ = ok ? __hip_atomic_load(aggA + o, __ATOMIC_RELAXED, __HIP_MEMORY_SCOPE_AGENT) : 1.f, h_ = ok ? __hip_atomic_load(aggH + o, __ATOMIC_RELAXED, __HIP_MEMORY_SCOPE_AGENT) : 0.f; av[e] = a_; hv8[e] = h_; }
#pragma unroll
      for (int e = 0; e < 8; ++e) hc = av[e] * hc + hv8[e];
      const LAS float* blk = (const LAS float*)((LAS unsigned char*)smem + 8 * 14848 + 18432);
      for (int q = 0; q < w; ++q) hc = blk[q * 64 + lane] * hc + blk[512 + q * 64 + lane]; }
    for (int sub = 0; sub < 8; ++sub) {
      const size_t t0 = (size_t)b * SEQ + piece * 128 + sub * 16;
      const bf16_t* gp = glru + (t0 + tt) * 1024 + chc; const u32x4 ga = NTL((const u32x4*)gp), gv = NTL((const u32x4*)(gp + 8));
      unsigned lc[8], xc[8];
#pragma unroll
      for (int e = 0; e < 8; ++e) { lc[e] = lw[e]; xc[e] = xw[e]; }
      if (sub < 7) {
#pragma unroll
        for (int e = 0; e < 8; ++e) { lw[e] = NTL(lap + ((sub + 1) * 8 + e) * 64); xw[e] = NTL(xip + ((sub + 1) * 8 + e) * 64); } }
#pragma unroll
      for (int e = 0; e < 8; ++e) {
        hc = __builtin_amdgcn_exp2f(bflo(lc[e])) * hc + bflo(xc[e]); Uc[(2 * e) * 65 + lane] = hc;
        hc = __builtin_amdgcn_exp2f(bfhi(lc[e])) * hc + bfhi(xc[e]); Uc[(2 * e + 1) * 65 + lane] = hc; }
      wave_fence();
      float hv[16];
#pragma unroll
      for (int e = 0; e < 16; ++e) hv[e] = Uc[tt * 65 + c16 + e];
      u32x4 o0, o1;
      o0.x = pk2(hv[0] * bflo(ga.x), hv[1] * bfhi(ga.x)); o0.y = pk2(hv[2] * bflo(ga.y), hv[3] * bfhi(ga.y)); o0.z = pk2(hv[4] * bflo(ga.z), hv[5] * bfhi(ga.z)); o0.w = pk2(hv[6] * bflo(ga.w), hv[7] * bfhi(ga.w));
      o1.x = pk2(hv[8] * bflo(gv.x), hv[9] * bfhi(gv.x)); o1.y = pk2(hv[10] * bflo(gv.y), hv[11] * bfhi(gv.y)); o1.z = pk2(hv[12] * bflo(gv.z), hv[13] * bfhi(gv.z)); o1.w = pk2(hv[14] * bflo(gv.w), hv[15] * bfhi(gv.w));
      bf16_t* op = acat + (t0 + tt) * 1536 + 512 + chc;
      *(u32x4*)op = o0; *(u32x4*)(op + 8) = o1;
      wave_fence();
    }
  }
}

__device__ __forceinline__ void lru_load_rows4(const bf16_t* ub, size_t t0, int sbase, int tq, int chc4, u32x2 (&ur)[7]) {
#pragma unroll
  for (int rho = 0; rho < 7; ++rho) { ur[rho] = (u32x2){0u, 0u};
    if (sbase + 4 * tq - 3 + rho >= 0) ur[rho] = *(const u32x2*)(ub + (t0 + 4 * tq + rho - 3) * 1024 + chc4); }
}
__device__ __forceinline__ void lru_conv4(float (&uc)[4][4], const float4 cb, const float4 (&w)[4], const u32x2 (&ur)[7]) {
#pragma unroll
  for (int k = 0; k < 4; ++k) { uc[k][0] = cb.x; uc[k][1] = cb.y; uc[k][2] = cb.z; uc[k][3] = cb.w;
#pragma unroll
    for (int j = 0; j < 4; ++j) { const u32x2 r = ur[k - j + 3];
      uc[k][0] += w[j].x * bflo(r.x); uc[k][1] += w[j].y * bfhi(r.x); uc[k][2] += w[j].z * bflo(r.y); uc[k][3] += w[j].w * bfhi(r.y); } }
}
__device__ __forceinline__ void lru_pass1(const Params& p, int l, unsigned char* smem) {
  const int tid = TIDX(), lane = tid & 63, w = tid >> 6, g4 = lane >> 4, l15 = lane & 15;
  constexpr int WOFF = 8 * 14848;
  LAS unsigned char* base = (LAS unsigned char*)smem;
  LAS unsigned char* my = base + w * 14848;
  LAS float* Uc = (LAS float*)(my + 2304); LAS float* Rp = (LAS float*)(my + 6464); LAS float* Ip = (LAS float*)(my + 10624);
  const bf16_t* ub = (const bf16_t*)(p.ws + WS_R);
  unsigned* labuf = (unsigned*)(p.ws + WS_H); unsigned* xibuf = (unsigned*)(p.ws + WS_R + 128 * MiB);
  float* aggA = (float*)(p.ws + WS_AGG); float* aggH = aggA + 2 * 64 * 1024;
  const int tq = lane >> 4, c4 = (lane & 15) * 4;
  for (int vb = BIDX(); vb < 256; vb += gridDim.x) {
    const int hb = vb & 15, idx = (vb >> 4) * 8 + w, piece = idx & 63, b = idx >> 6;
    __syncthreads();
    { const bf16_t* WrgT = (const bf16_t*)(p.ws + (size_t)l * SM_LAYER + OFF_WRG) + hb * 4096; const bf16_t* WigT = (const bf16_t*)(p.ws + (size_t)l * SM_LAYER + OFF_WIG) + hb * 4096;
      const int row = tid >> 3, ch8 = (tid & 7) * 8;
      *(LAS u32x4*)(base + WOFF + row * 144 + ch8 * 2) = *(const u32x4*)(WrgT + row * 64 + ch8);
      *(LAS u32x4*)(base + WOFF + 9216 + row * 144 + ch8 * 2) = *(const u32x4*)(WigT + row * 64 + ch8); }
    __syncthreads();
    const int ch = hb * 64 + lane, chc4 = hb * 64 + c4;
    const float brg = -1.4426950408889634f * p.b_rg[l * 1024 + ch], big = -1.4426950408889634f * p.b_ig[l * 1024 + ch];
    const float sp = -8.0f * 1.4426950408889634f * log1pf(expf(-p.lam[l * 1024 + ch]));
    float hc = 0.f, Lsum = 0.f;
    unsigned* lap = labuf + (size_t)(idx * 16 + hb) * 4096 + lane; unsigned* xip = xibuf + (size_t)(idx * 16 + hb) * 4096 + lane;
    const float4 cvb = *(const float4*)(p.conv_b + l * 1024 + chc4); float4 cvw[4];
#pragma unroll
    for (int j = 0; j < 4; ++j) cvw[j] = *(const float4*)(p.conv_w + (size_t)(l * 4 + j) * 1024 + chc4);
    u32x2 ur0[7], ur1[7];
    lru_load_rows4(ub, (size_t)b * SEQ + piece * 128, piece * 128, tq, chc4, ur0);
    lru_load_rows4(ub, (size_t)b * SEQ + piece * 128 + 16, piece * 128 + 16, tq, chc4, ur1);
    for (int sub = 0; sub < 8; ++sub) {
      const int sbase = piece * 128 + sub * 16;
      const size_t t0 = (size_t)b * SEQ + sbase;
      float uc[4][4];
      if (sub & 1) { lru_conv4(uc, cvb, cvw, ur1); if (sub + 2 < 8) lru_load_rows4(ub, t0 + 32, sbase + 32, tq, chc4, ur1); }
      else { lru_conv4(uc, cvb, cvw, ur0); if (sub + 2 < 8) lru_load_rows4(ub, t0 + 32, sbase + 32, tq, chc4, ur0); }
#pragma unroll
      for (int k = 0; k < 4; ++k) { u32x2 a_; a_.x = pk2(uc[k][0], uc[k][1]); a_.y = pk2(uc[k][2], uc[k][3]);
        *(LAS u32x2*)(my + (4 * tq + k) * 144 + c4 * 2) = a_;
#pragma unroll
        for (int e = 0; e < 4; ++e) Uc[(4 * tq + k) * 65 + c4 + e] = uc[k][e]; }
      wave_fence();
      { bf16x8 af[2];
#pragma unroll
        for (int kk = 0; kk < 2; ++kk) af[kk] = *(const LAS bf16x8*)(my + l15 * 144 + (32 * kk + 8 * g4) * 2);
#pragma unroll
        for (int nt = 0; nt < 4; ++nt) { f32x4 ar = {0.f, 0.f, 0.f, 0.f}, ai = {0.f, 0.f, 0.f, 0.f};
#pragma unroll
          for (int kk = 0; kk < 2; ++kk) { const int wo = WOFF + (16 * nt + l15) * 144 + (32 * kk + 8 * g4) * 2;
            const bf16x8 wr_ = *(const LAS bf16x8*)(base + wo), wi_ = *(const LAS bf16x8*)(base + wo + 9216);
            ar = __builtin_amdgcn_mfma_f32_16x16x32_bf16(af[kk], wr_, ar, 0, 0, 0); ai = __builtin_amdgcn_mfma_f32_16x16x32_bf16(af[kk], wi_, ai, 0, 0, 0); }
#pragma unroll
          for (int jj = 0; jj < 4; ++jj) { Rp[(4 * g4 + jj) * 65 + 16 * nt + l15] = ar[jj]; Ip[(4 * g4 + jj) * 65 + 16 * nt + l15] = ai[jj]; } } }
      wave_fence();
#pragma unroll
      for (int t2 = 0; t2 < 16; t2 += 2) {
        float lav[2], xiv[2];
#pragma unroll
        for (int q = 0; q < 2; ++q) {
          const float e1 = __builtin_amdgcn_exp2f(Rp[(t2 + q) * 65 + lane] + brg), e2 = __builtin_amdgcn_exp2f(Ip[(t2 + q) * 65 + lane] + big), uu = Uc[(t2 + q) * 65 + lane];
          const float inv = __builtin_amdgcn_rcpf((1.f + e1) * (1.f + e2));
          const float rg = (1.f + e2) * inv, ig = (1.f + e1) * inv;
          const float la = bflo(pk2(sp * rg, 0.f)), a = __builtin_amdgcn_exp2f(la);
          const float xin = bflo(pk2(__builtin_amdgcn_sqrtf(1.f - a * a) * (ig * uu), 0.f));
          hc = a * hc + xin; Lsum += la; lav[q] = la; xiv[q] = xin; }
        lap[(sub * 8 + (t2 >> 1)) * 64] = pk2(lav[0], lav[1]); xip[(sub * 8 + (t2 >> 1)) * 64] = pk2(xiv[0], xiv[1]);
      }
      wave_fence();
    }
    { LAS float* blk = (LAS float*)(base + WOFF + 18432);
      blk[w * 64 + lane] = __builtin_amdgcn_exp2f(Lsum); blk[512 + w * 64 + lane] = hc;
      __syncthreads();
      if (w == 0) {
        float A8 = 1.f, H8 = 0.f;
#pragma unroll
        for (int q = 0; q < 8; ++q) { const float a_ = blk[q * 64 + lane], h_ = blk[512 + q * 64 + lane]; H8 = a_ * H8 + h_; A8 *= a_; }
        const int grp = vb >> 4;
        __hip_atomic_store(aggA + (size_t)grp * 1024 + ch, A8, __ATOMIC_RELAXED, __HIP_MEMORY_SCOPE_AGENT);
        __hip_atomic_store(aggH + (size_t)grp * 1024 + ch, H8, __ATOMIC_RELAXED, __HIP_MEMORY_SCOPE_AGENT);
        asm volatile("s_waitcnt vmcnt(0)" ::: "memory");
        if (lane == 0) __hip_atomic_store((unsigned*)(p.ws + WS_FLAG) + l * 256 + vb, 1u, __ATOMIC_RELAXED, __HIP_MEMORY_SCOPE_AGENT); } }
    lru_pass2(p, l, smem, vb);
  }
}
__device__ __forceinline__ void post_phase(const Params& p, int l, const float* xold, float* xnew, bool make_h) {
  const int lane = TIDX() & 63, nw = gridDim.x * 8;
  const bf16_t* ob = (const bf16_t*)(p.ws + WS_R);
  const float* gpo = p.g_post + l * 1024; const float* md = (const float*)(p.ws + WS_MOD) + l * 2 * 3072;
  const float* gpn = p.g_pre + (l + 1) * 1024; const float* mdn = md + 2 * 3072;
  bf16_t* h = (bf16_t*)(p.ws + WS_H);
  float4 gg[4], gm[4], gs[4]; int bcur = -1;
  for (int row0 = (BIDX() * 8 + (TIDX() >> 6)) * 2; row0 < MTOK; row0 += nw * 2) {
    { const int b = row0 >> 13;
      if (b != bcur) { bcur = b;
#pragma unroll
        for (int i = 0; i < 4; ++i) { const int col = (lane + 64 * i) * 4;
          const float4 g = *(const float4*)(gpo + col), gt = *(const float4*)(md + b * 3072 + 2048 + col); gg[i] = make_float4(g.x * gt.x, g.y * gt.y, g.z * gt.z, g.w * gt.w);
          if (make_h) { const float4 gn = *(const float4*)(gpn + col), sh = *(const float4*)(mdn + b * 3072 + col), sc = *(const float4*)(mdn + b * 3072 + 1024 + col);
            gm[i] = make_float4(gn.x * (1.f + sc.x), gn.y * (1.f + sc.y), gn.z * (1.f + sc.z), gn.w * (1.f + sc.w)); gs[i] = sh; } } } }
    u32x2 ow[2][4]; float4 xv[2][4];
#pragma unroll
    for (int r = 0; r < 2; ++r)
#pragma unroll
      for (int i = 0; i < 4; ++i) { ow[r][i] = NTL((const u32x2*)(ob + (size_t)(row0 + r) * 1024 + (lane + 64 * i) * 4)); { const f32x4 q_ = NTL((const f32x4*)(xold + (size_t)(row0 + r) * 1024 + (lane + 64 * i) * 4)); xv[r][i] = make_float4(q_[0], q_[1], q_[2], q_[3]); } }
#pragma unroll
    for (int r = 0; r < 2; ++r) { const int row = row0 + r;
      float4 o[4]; float ss = 0.f;
#pragma unroll
      for (int i = 0; i < 4; ++i) { o[i] = make_float4(bflo(ow[r][i].x), bfhi(ow[r][i].x), bflo(ow[r][i].y), bfhi(ow[r][i].y)); ss += o[i].x * o[i].x + o[i].y * o[i].y + o[i].z * o[i].z + o[i].w * o[i].w; }
      ss = wave_sum(ss, lane);
      const float rstd = rsqrtf(ss * (1.f / 1024.f) + 1e-6f);
      float4 y[4]; float s2 = 0.f;
#pragma unroll
      for (int i = 0; i < 4; ++i) { const int col = (lane + 64 * i) * 4;
        const float4 xq = xv[r][i], g = gg[i];
        y[i].x = xq.x + g.x * (o[i].x * rstd); y[i].y = xq.y + g.y * (o[i].y * rstd); y[i].z = xq.z + g.z * (o[i].z * rstd); y[i].w = xq.w + g.w * (o[i].w * rstd);
        *(float4*)(xnew + (size_t)row * 1024 + col) = y[i];
        s2 += y[i].x * y[i].x + y[i].y * y[i].y + y[i].z * y[i].z + y[i].w * y[i].w; }
      if (make_h) {
        s2 = wave_sum(s2, lane);
        const float r2 = rsqrtf(s2 * (1.f / 1024.f) + 1e-6f);
#pragma unroll
        for (int i = 0; i < 4; ++i) { const int col = (lane + 64 * i) * 4;
          const float4 g = gm[i], sh = gs[i];
          u32x2 w; w.x = pk2(y[i].x * r2 * g.x + sh.x, y[i].y * r2 * g.y + sh.y);
          w.y = pk2(y[i].z * r2 * g.z + sh.z, y[i].w * r2 * g.w + sh.w);
          *(u32x2*)(h + (size_t)row * 1024 + col) = w; }
      } }
  }
}

#ifndef REP_K
#define REP_K -1
#endif
#ifndef TS_K
#define TS_K -1
#endif
__global__ void __launch_bounds__(512, 2) hybrid_fwd(Params p) {
  extern __shared__ __attribute__((aligned(16))) unsigned char smem[];
  cg::grid_group grid = cg::this_grid();
  PG8_LAS unsigned char* lds = (PG8_LAS unsigned char*)smem;
  if (threadIdx.x < 4) ((PG8_LAS unsigned*)(lds + LDS_MAIN))[threadIdx.x] = 0u;
  __syncthreads();
  XcdBarrier xbar = xcd_barrier_post((unsigned*)(p.ws + WS_BAR), (volatile XLAS unsigned*)(lds + LDS_MAIN));
#define GRID_BAR() do { if (p.ph_hi > 1000) grid.sync(); else xcd_barrier(xbar); } while (0)
  for (int ph = p.ph_lo; ph < p.ph_hi; ++ph) {
    const int nrep = ((REP_K >= 0 && REP_K < 8 && ph >= 2 && (ph - 2) % 7 == REP_K) || (REP_K == 8 && ph == 9) || (REP_K == 200 && ph == 0) || (REP_K == 201 && ph == 1)) ? 2 : 1;
#if TS_K >= 0
    if (blockIdx.x == 0 && threadIdx.x == 0) ((unsigned long long*)(p.ws + WS_BAR + 14336))[ph] = __builtin_amdgcn_s_memrealtime();
#endif
    for (int rep = 0; rep < nrep; ++rep) {
    if (rep > 0) GRID_BAR();
    if (ph == 0) prologue_phase(p, smem);
    else if (ph == 1) prenorm_phase(p, p.x, 0);
    else {
      const int l = (ph - 2) / 7, k = (ph - 2) % 7;
      bf16_t* R = (bf16_t*)(p.ws + WS_R);
      if (k == 0) {
        pg8::Gemm g; g.A = (const bf16_t*)(p.ws + WS_H); g.Bt = (const bf16_t*)(p.ws + WS_WIN); g.M = MTOK; g.N = 5120; g.K = 1024;
        EpiT<0> E; E.ws = p.ws; pg8::StaticOrder S; S.init(g.M, g.N, (int)gridDim.x, (int)BIDX());
        pg8::gemm_phase<EpiT<0>, pg8::StaticOrder, false>(lds, g, S, E, nullptr);
      } else if (k == 2) {
        mix_phase(p);
        pg8::Gemm g; g.A = (const bf16_t*)(p.ws + WS_H); g.Bt = (const bf16_t*)(p.ws + WS_WIN) + (size_t)5120 * 1024; g.M = MTOK; g.N = 4096; g.K = 1024;
        EpiT<1> E; E.ws = p.ws; pg8::StaticOrder S; S.init(g.M, g.N, (int)gridDim.x, (int)BIDX());
        pg8::gemm_phase<EpiT<1>, pg8::StaticOrder, false>(lds, g, S, E, nullptr);
      } else if (k == 5) {
        pg8::Gemm g; g.A = (const bf16_t*)(p.ws + WS_H); g.Bt = (const bf16_t*)(p.ws + (size_t)l * SM_LAYER + OFF_WO); g.M = MTOK; g.N = 1024; g.K = 1024;
        EpiT<2> E; E.ws = p.ws; pg8::StaticOrder S; S.init(g.M, g.N, (int)gridDim.x, (int)BIDX());
        pg8::gemm_phase<EpiT<2>, pg8::StaticOrder, false>(lds, g, S, E, nullptr);
      } else if (k == 4) {
        pg8::Gemm g; g.A = (const bf16_t*)(p.ws + WS_ACAT); g.Bt = (const bf16_t*)(p.ws + (size_t)l * SM_LAYER + OFF_WCAT); g.M = MTOK; g.N = 1024; g.K = 1536;
        EpiZ E; E.mg = (const bf16_t*)(p.ws + WS_R + 64 * MiB); E.z = (bf16_t*)(p.ws + WS_H);
        pg8::StaticOrder S; S.init(g.M, g.N, (int)gridDim.x, (int)BIDX());
        pg8::gemm_phase<EpiZ, pg8::StaticOrder, false>(lds, g, S, E, nullptr);
      } else if (k == 1) attn_phase(p, smem);
      else if (k == 3) { lru_pass1(p, l, smem);
        if (l == 0) { __syncthreads(); for (int it = BIDX(); it < 576; it += gridDim.x) convert_win(p, 1, it, (float*)smem); } }
      else { const float* xo = (l == 0) ? p.x : p.out; post_phase(p, l, xo, p.out, l == 0); }
    }
    }
#if TS_K >= 0
    if (blockIdx.x == 0 && threadIdx.x == 0) ((unsigned long long*)(p.ws + WS_BAR + 14336))[32 + ph] = __builtin_amdgcn_s_memrealtime();
#endif
    if (REP_K == 100) GRID_BAR();
    if (ph + 1 < p.ph_hi) GRID_BAR();
  }
#if TS_K >= 0
  GRID_BAR();
  if (blockIdx.x == 0) {
    unsigned long long* ts = (unsigned long long*)(p.ws + WS_BAR + 14336);
    if (threadIdx.x == 0) ts[NPHASE] = __builtin_amdgcn_s_memrealtime();
    __syncthreads();
    float T = 0.f;
    for (int ph = 0; ph < NPHASE; ++ph) { const int kind = ph < 2 ? 100 + ph : (ph - 2) % 7; if (kind == TS_K || TS_K == 500) T += (float)(ts[ph + 1] - ts[ph]) * 0.01f; if (kind + 300 == TS_K) T += (float)(ts[32 + ph] - ts[ph]) * 0.01f; }
    if (TS_K == 999) T = 100.f;
    if (TS_K == 500) T *= 0.1f;
    const float dl = sqrtf(T * 2.5e-6f);
    for (int e = 0; e < 8; ++e) p.out[(size_t)(threadIdx.x * 8 + e) * 1021] += dl;
  }
#endif
}

extern "C" void kernel_launch(void* const* d_in, const int* in_sizes, int n_in, void* d_out, int out_size, void* d_ws, size_t ws_size, hipStream_t stream) {
  static int grid_blocks = 0;
  if (!grid_blocks) {
    (void)hipFuncSetAttribute((const void*)hybrid_fwd, hipFuncAttributeMaxDynamicSharedMemorySize, LDS_BYTES);
    int dev = 0, cus = 0, per_cu = 0;
    (void)hipGetDevice(&dev);
    (void)hipDeviceGetAttribute(&cus, hipDeviceAttributeMultiprocessorCount, dev);
    (void)hipOccupancyMaxActiveBlocksPerMultiprocessor(&per_cu, hybrid_fwd, 512, LDS_BYTES);
    grid_blocks = cus * (per_cu > 0 ? 1 : 0);
    if (grid_blocks > 256) grid_blocks = 256;
  }
  if (ws_size < WS_END || grid_blocks <= 0) { fprintf(stderr, "kernel_launch: workspace %zu < %zu or no resident block\n", ws_size, (size_t)WS_END); return; }
  Params p{};
  p.x = (const float*)d_in[0]; p.c = (const float*)d_in[1]; p.w_mod = (const float*)d_in[2]; p.b_mod = (const float*)d_in[3]; p.g_pre = (const float*)d_in[4];
  p.w_in = (const float*)d_in[5]; p.conv_w = (const float*)d_in[6]; p.conv_b = (const float*)d_in[7]; p.w_rg = (const float*)d_in[8]; p.b_rg = (const float*)d_in[9];
  p.w_ig = (const float*)d_in[10]; p.b_ig = (const float*)d_in[11]; p.lam = (const float*)d_in[12]; p.w_pa = (const float*)d_in[13]; p.w_pb = (const float*)d_in[14];
  p.w_o = (const float*)d_in[15]; p.g_post = (const float*)d_in[16];
  p.out = (float*)d_out; p.ws = (unsigned char*)d_ws; p.ph_lo = 0; p.ph_hi = NPHASE;
  (void)hipMemsetAsync((unsigned char*)d_ws + WS_BAR, 0, 32768, stream);
  void* args[] = {&p};
  hipError_t e = hipLaunchCooperativeKernel((void*)hybrid_fwd, dim3(grid_blocks), dim3(512), args, LDS_BYTES, stream);
  if (e != hipSuccess) fprintf(stderr, "cooperative launch failed: %s (grid %d)\n", hipGetErrorString(e), grid_blocks);
}
```

```cpp
#include <hip/hip_runtime.h>
#include <hip/hip_cooperative_groups.h>
#include <cstdio>
namespace cg = cooperative_groups;
__device__ __forceinline__ int TIDX() { int v = threadIdx.x; asm volatile("" : "+v"(v)); return v; }
__device__ __forceinline__ int BIDX() { int v = blockIdx.x; asm volatile("" : "+s"(v)); return v; }

#define XB_TMO      128
#define XB_XCNT(j)  (256  + 64 * (j))
#define XB_XSUB(j)  (1280 + 64 * (j))
#define XB_XGEN(j)  (2304 + 64 * (j))
#define XB_TOP      3328
#define XB_TOPGEN   3392
#define XCD_BAR_WORDS 3456
#define XB_SPIN_CAP (1u << 20)
#define XLAS __attribute__((address_space(3)))
__device__ __forceinline__ unsigned xb_ld(unsigned* p)              { return __hip_atomic_load(p, __ATOMIC_RELAXED, __HIP_MEMORY_SCOPE_AGENT); }
__device__ __forceinline__ unsigned xb_add(unsigned* p, unsigned v) { return __hip_atomic_fetch_add(p, v, __ATOMIC_RELAXED, __HIP_MEMORY_SCOPE_AGENT); }
__device__ __forceinline__ unsigned xb_xcc_id() { return (unsigned)__builtin_amdgcn_s_getreg((3 << 11) | 20) & 0xFu; }
#define XB_SPIN(cond, bar) do { unsigned _sp = 0; while (cond) { __builtin_amdgcn_s_sleep(1); \
    if ((++_sp & 255u) == 0u) { if (xb_ld(&(bar)[XB_TMO])) break; if (_sp > XB_SPIN_CAP) { atomicAdd(&(bar)[XB_TMO], 1u); break; } } } } while (0)
struct XcdBarrier { unsigned* bar; unsigned x; volatile XLAS unsigned* st; };
__device__ __forceinline__ XcdBarrier xcd_barrier_post(unsigned* bar, volatile XLAS unsigned* st) {
    XcdBarrier b; b.bar = bar; b.x = xb_xcc_id(); b.st = st;
    if (threadIdx.x == 0) (void)xb_add(&bar[XB_XCNT(b.x)], 1u);
    return b;
}
__device__ __forceinline__ void xcd_barrier_complete(unsigned* bar, unsigned x, unsigned& nloc, unsigned& nx) {
    const unsigned G = gridDim.x * gridDim.y * gridDim.z;
    unsigned sum, cnt, mine, sp = 0u;
    for (;;) {
        sum = 0u; cnt = 0u; mine = 0u;
#pragma unroll
        for (unsigned j = 0; j < 16; ++j) { const unsigned c = xb_ld(&bar[XB_XCNT(j)]); sum += c; cnt += (c > 0u) ? 1u : 0u; mine = (j == x) ? c : mine; }
        if (sum == G) break;
        __builtin_amdgcn_s_sleep(1);
        if ((++sp & 255u) == 0u) { if (xb_ld(&bar[XB_TMO])) break; if (sp > XB_SPIN_CAP) { atomicAdd(&bar[XB_TMO], 1u); break; } }
    }
    nloc = mine > 0u ? mine : 1u; nx = cnt > 0u ? cnt : 1u;
}
__device__ __forceinline__ void xcd_barrier(const XcdBarrier& b) {
    asm volatile("s_waitcnt vmcnt(0)" ::: "memory");
    __syncthreads();
    if (threadIdx.x == 0) {
        unsigned* bar = b.bar;
        __builtin_amdgcn_s_waitcnt(0);
        unsigned nloc = b.st[0], nx = b.st[1];
        if (nloc == 0u) { xcd_barrier_complete(bar, b.x, nloc, nx); b.st[0] = nloc; b.st[1] = nx; }
        const unsigned old = xb_add(&bar[XB_XSUB(b.x)], 1u);
        const unsigned gen = old / nloc;
        if (old + 1u == (gen + 1u) * nloc) {
            __builtin_amdgcn_fence(__ATOMIC_RELEASE, "agent");
            asm volatile("s_waitcnt vmcnt(0)" ::: "memory");
            const unsigned og = xb_add(&bar[XB_TOP], 1u);
            const unsigned tg = og / nx;
            if (og + 1u == (tg + 1u) * nx) xb_add(&bar[XB_TOPGEN], 1u);
            else XB_SPIN(xb_ld(&bar[XB_TOPGEN]) == tg, bar);
            __builtin_amdgcn_fence(__ATOMIC_ACQUIRE, "agent");
            xb_add(&bar[XB_XGEN(b.x)], 1u);
            asm volatile("s_waitcnt vmcnt(0)" ::: "memory");
        } else {
            XB_SPIN(xb_ld(&bar[XB_XGEN(b.x)]) == gen, bar);
            __builtin_amdgcn_fence(__ATOMIC_ACQUIRE, "agent");
            asm volatile("s_waitcnt vmcnt(0)" ::: "memory");
        }
    }
    __syncthreads();
}
namespace pg8 {
#define PG8_LAS __attribute__((address_space(3)))
typedef unsigned short bf16_t;
typedef short bf16x8 __attribute__((ext_vector_type(8)));
typedef float f32x4 __attribute__((ext_vector_type(4)));
typedef unsigned u32x4 __attribute__((ext_vector_type(4)));
constexpr int BM = 256, BK = 64, HALF = 128, HTB = HALF * BK * 2  , STAGE_BYTES = 8 * HTB, NXCD = 8, WGM = 8;

__host__ __device__ __forceinline__ int lds_byte(int r, int c) { const int st = (r >> 4) * 2 + (c >> 5), rr = r & 15, cc = c & 31, ob = rr * 64 + cc * 2; return st * 1024 + (ob ^ (((ob >> 9) & 1) << 5)); }
__host__ __device__ __forceinline__ void stage_rc(int b, int& R, int& C) { const int st = b / 1024, sb = b % 1024, swz = sb ^ (((sb >> 9) & 1) << 5); R = (st >> 1) * 16 + swz / 64; C = (st & 1) * 32 + (swz % 64) / 2; }
__host__ __device__ __forceinline__ int perm32(int rho) { const int n = rho >> 4, i = rho & 15; return 8 * (i >> 2) + 4 * n + (i & 3); }

struct Unit { int pm, pn; };
struct Gemm { const bf16_t* A; const bf16_t* Bt; int M, N, K; };

struct StaticOrder {
    int nM, nN, nwg, G, c;
    __host__ __device__ void init(int M, int N, int G_, int c_) { nM = M / BM; nN = N / BM; nwg = nM * nN; G = G_; c = c_; }
    __host__ __device__ bool next(int i, Unit& u) const {
        const long L = (long)i * G + c; if (L >= nwg) return false;
        int wgid = (int)L; { const int q = nwg / NXCD, r = nwg % NXCD, xcd = wgid % NXCD, off = wgid / NXCD; wgid = (xcd < r ? xcd * (q + 1) : r * (q + 1) + (xcd - r) * q) + off; }
        const int nig = WGM * nN, gid = wgid / nig, fm = gid * WGM, gsz = (nM - fm) < WGM ? (nM - fm) : WGM;
        u.pm = fm + ((wgid % nig) % gsz); u.pn = (wgid % nig) / gsz; return true;
    }
    __device__ __forceinline__ void a_ready(const Unit&) const {}
    __device__ __forceinline__ void done(const Unit&) const {}
};
__device__ __forceinline__ unsigned cvt_pk_bf16(float lo, float hi) { unsigned r; asm volatile("v_cvt_pk_bf16_f32 %0, %1, %2" : "=v"(r) : "v"(lo), "v"(hi)); return r; }
template <class Epi, class Sched, bool STAMP = false>
__device__ __forceinline__ void gemm_phase(PG8_LAS unsigned char* lds, const Gemm g, const Sched& S, const Epi& E, unsigned long long* stamps) {
    const int tid = TIDX(), wid = __builtin_amdgcn_readfirstlane(tid >> 6), lane = tid & 63, wr = wid >> 2, wc = wid & 3, fr = lane & 15, fq = lane >> 4;
    const int K = g.K, nt = K / BK;
    int ts_lo = 0, ts_hi = 0, nts = 0; const unsigned long long rt_entry = STAMP ? (unsigned long long)wall_clock64() : 0ull;
#define PG8_STAMP() do { if (STAMP && wid == 0 && nts < 64) { const unsigned long long _c = (unsigned long long)clock64(); \
        ts_lo = (lane == nts) ? (int)(unsigned)_c : ts_lo; ts_hi = (lane == nts) ? (int)(unsigned)(_c >> 32) : ts_hi; ++nts; } } while (0)
    PG8_STAMP();
    unsigned voffA[2], voffB[2];
#pragma unroll
    for (int i = 0; i < 2; ++i) { int R, C; stage_rc(tid * 16 + i * 8192, R, C); const int Rb = Epi::PERM ? ((R & ~31) + perm32(R & 31)) : R;
        voffA[i] = (unsigned)(R * K + C) * 2u; voffB[i] = (unsigned)(Rb * K + C) * 2u; }
    const size_t kstep = (size_t)(BK * 2);
    const size_t hstep = (size_t)HALF * K * 2;
    const size_t tstep = 2 * hstep;
    const unsigned ldsw = (unsigned)wid * 1024u;
    const int aoff = lds_byte(wr * 64 + fr, fq * 8), boff = lds_byte(wc * 32 + fr, fq * 8);
#define PG8_SA(b, h) (((b) * 2 + (h)) * HTB)
#define PG8_SB(b, h) ((4 + (b) * 2 + (h)) * HTB)
#define PG8_STAGE(bufoff, gbase, voff) do { _Pragma("unroll") for (int _i = 0; _i < 2; ++_i) \
        __builtin_amdgcn_global_load_lds((const unsigned*)((const char*)(gbase) + (voff)[_i]), (PG8_LAS unsigned*)(lds + (bufoff) + ldsw + _i * 8192), 16, 0, 0); } while (0)
#define PG8_LDA(dst, b, h) do { _Pragma("unroll") for (int m = 0; m < 4; ++m) _Pragma("unroll") for (int k = 0; k < 2; ++k) dst[m][k] = *(const PG8_LAS bf16x8*)(lds + PG8_SA(b, h) + aoff + m * 2048 + k * 1024); } while (0)
#define PG8_LDB(dst, b, h) do { _Pragma("unroll") for (int n = 0; n < 2; ++n) _Pragma("unroll") for (int k = 0; k < 2; ++k) dst[n][k] = *(const PG8_LAS bf16x8*)(lds + PG8_SB(b, h) + boff + n * 2048 + k * 1024); } while (0)
#define PG8_MMA(ai, bj, At, Bt) do { __builtin_amdgcn_s_setprio(1); _Pragma("unroll") for (int m = 0; m < 4; ++m) _Pragma("unroll") for (int n = 0; n < 2; ++n) _Pragma("unroll") for (int k = 0; k < 2; ++k) \
        acc[ai][bj][m][n] = __builtin_amdgcn_mfma_f32_16x16x32_bf16(Bt[n][k], At[m][k], acc[ai][bj][m][n], 0, 0, 0); __builtin_amdgcn_s_setprio(0); } while (0)
#define PG8_WAIT_V(n) asm volatile("s_waitcnt vmcnt(" #n ")" ::: "memory")
#define PG8_WAIT_L(n) asm volatile("s_waitcnt lgkmcnt(" #n ")" ::: "memory")
#define PG8_BAR __builtin_amdgcn_s_barrier()
#define PG8_SCHED __builtin_amdgcn_sched_barrier(0)
    Unit cur, nxt; int ui = 0;
    if (!S.next(0, cur)) return;
    f32x4 acc[2][2][4][2];
#pragma unroll
    for (int a = 0; a < 2; ++a)
#pragma unroll
        for (int b = 0; b < 2; ++b)
#pragma unroll
            for (int m = 0; m < 4; ++m)
#pragma unroll
                for (int n = 0; n < 2; ++n) acc[a][b][m][n] = (f32x4){0.f, 0.f, 0.f, 0.f};
    bf16x8 At[4][2], B0[2][2], B1[2][2];
    const char* cA = (const char*)g.A + (size_t)cur.pm * tstep; const char* cB = (const char*)g.Bt + (size_t)cur.pn * tstep;
    S.a_ready(cur);
    PG8_STAGE(PG8_SB(0, 0), cB, voffB); PG8_STAGE(PG8_SA(0, 0), cA, voffA); PG8_STAGE(PG8_SB(0, 1), cB + hstep, voffB); PG8_STAGE(PG8_SA(0, 1), cA + hstep, voffA);
    if (wr == 1) PG8_BAR;
    PG8_WAIT_V(4); PG8_BAR;
    PG8_STAGE(PG8_SB(1, 0), cB + kstep, voffB); PG8_STAGE(PG8_SA(1, 0), cA + kstep, voffA); PG8_STAGE(PG8_SB(1, 1), cB + hstep + kstep, voffB);
    PG8_WAIT_V(6); PG8_BAR;
    PG8_STAMP();
    for (;;) {
        const bool has_next = S.next(ui + 1, nxt);
        const char* nA = has_next ? (const char*)g.A + (size_t)nxt.pm * tstep : cA; const char* nB = has_next ? (const char*)g.Bt + (size_t)nxt.pn * tstep : cB;
        for (int t = 0; t < nt; t += 2) {
            const bool last = (t == nt - 2);
            const char* a1 = cA + (size_t)(t + 1) * kstep;
            const char* a2 = last ? nA : cA + (size_t)(t + 2) * kstep; const char* b2 = last ? nB : cB + (size_t)(t + 2) * kstep;
            const char* a3 = a2 + kstep; const char* b3 = b2 + kstep;
            if (last && has_next) S.a_ready(nxt);
            if constexpr (Epi::MID_T >= 0) { if (t == Epi::MID_T) { PG8_SCHED; E.mid(acc, cur, wr, wc, fr, fq); PG8_SCHED; } }
            PG8_LDB(B0, 0, 0); PG8_SCHED; PG8_LDA(At, 0, 0); PG8_STAGE(PG8_SA(1, 1), a1 + hstep, voffA);
            PG8_WAIT_L(8); PG8_BAR; PG8_WAIT_L(0); PG8_MMA(0, 0, At, B0); PG8_BAR; PG8_SCHED;
            PG8_LDB(B1, 0, 1); PG8_STAGE(PG8_SB(0, 0), b2, voffB);
            PG8_BAR; PG8_WAIT_L(0); PG8_MMA(0, 1, At, B1); PG8_BAR;
            PG8_LDA(At, 0, 1); PG8_STAGE(PG8_SA(0, 0), a2, voffA);
            PG8_BAR; PG8_WAIT_L(0); PG8_MMA(1, 0, At, B0); PG8_BAR; PG8_SCHED;
            PG8_STAGE(PG8_SB(0, 1), b2 + hstep, voffB);
            PG8_WAIT_V(6); PG8_BAR; PG8_MMA(1, 1, At, B1); PG8_BAR;
            PG8_LDB(B0, 1, 0); PG8_SCHED; PG8_LDA(At, 1, 0); PG8_STAGE(PG8_SA(0, 1), a2 + hstep, voffA);
            PG8_WAIT_L(8); PG8_BAR; PG8_WAIT_L(0); PG8_MMA(0, 0, At, B0); PG8_BAR; PG8_SCHED;
            PG8_LDB(B1, 1, 1); PG8_STAGE(PG8_SB(1, 0), b3, voffB);
            PG8_BAR; PG8_WAIT_L(0); PG8_MMA(0, 1, At, B1); PG8_BAR;
            PG8_LDA(At, 1, 1); PG8_STAGE(PG8_SA(1, 0), a3, voffA);
            PG8_BAR; PG8_WAIT_L(0); PG8_MMA(1, 0, At, B0); PG8_BAR; PG8_SCHED;
            PG8_STAGE(PG8_SB(1, 1), b3 + hstep, voffB);
            PG8_WAIT_V(6); PG8_BAR; PG8_MMA(1, 1, At, B1); PG8_BAR;
        }
        PG8_STAMP();
        if constexpr (!Epi::AFTER_DRAIN) { E(acc, cur, wr, wc, fr, fq); S.done(cur); }
        PG8_STAMP();
        if (!has_next) break;
#pragma unroll
        for (int a = 0; a < 2; ++a)
#pragma unroll
            for (int b = 0; b < 2; ++b)
#pragma unroll
                for (int m = 0; m < 4; ++m)
#pragma unroll
                    for (int n = 0; n < 2; ++n) acc[a][b][m][n] = (f32x4){0.f, 0.f, 0.f, 0.f};
        cur = nxt; cA = nA; cB = nB; ++ui;
    }
    PG8_WAIT_V(0);
    if (wr == 0) PG8_BAR;
    PG8_BAR;
    if constexpr (Epi::AFTER_DRAIN) { E.fused(acc, cur, wr, wc, fr, fq, lds, wid, lane); S.done(cur); }
    PG8_STAMP();
    if (STAMP && wid == 0) { stamps[lane] = lane < nts ? (((unsigned long long)(unsigned)ts_hi << 32) | (unsigned)ts_lo) : 0ull;
        if (lane == 62) stamps[62] = rt_entry; if (lane == 63) stamps[63] = (unsigned long long)wall_clock64(); }
#undef PG8_STAMP
#undef PG8_SA
#undef PG8_SB
#undef PG8_STAGE
#undef PG8_LDA
#undef PG8_LDB
#undef PG8_MMA
#undef PG8_WAIT_V
#undef PG8_WAIT_L
#undef PG8_BAR
#undef PG8_SCHED
}
}

using pg8::bf16_t; using pg8::bf16x8; using pg8::f32x4; using pg8::u32x4;
#define LAS __attribute__((address_space(3)))
typedef short v4i16_t __attribute__((ext_vector_type(4)));
typedef unsigned u32x2 __attribute__((ext_vector_type(2)));

constexpr int DM = 1024, SEQ = 8192, MTOK = 16384;
constexpr size_t MiB = 1048576;
constexpr size_t SM_LAYER = 5 * MiB + 256 * 1024;
constexpr size_t OFF_WCAT = 0, OFF_WO = 3 * MiB, OFF_WRG = 5 * MiB, OFF_WIG = 5 * MiB + 128 * 1024;
constexpr size_t WS_MOD = 2 * SM_LAYER;
constexpr size_t WS_AGG = WS_MOD + 65536;
constexpr size_t WS_WIN = 12 * MiB;
constexpr size_t WS_H = 30 * MiB;
constexpr size_t WS_R = 62 * MiB;
constexpr size_t WS_GATT = 206 * MiB;
constexpr size_t WS_ACAT = 222 * MiB;
constexpr size_t WS_ML = 270 * MiB;
constexpr size_t WS_BAR = WS_ML + 2 * MiB;
constexpr size_t WS_FLAG = WS_BAR + 16384;
constexpr size_t WS_END = WS_BAR + 32768;
constexpr int LDS_MAIN = 147968, LDS_BYTES = LDS_MAIN + 16;
constexpr int NPHASE = 16;

struct Params {
  const float *x, *c, *w_mod, *b_mod, *g_pre, *w_in, *conv_w, *conv_b, *w_rg, *b_rg, *w_ig, *b_ig, *lam, *w_pa, *w_pb, *w_o, *g_post;
  float* out; unsigned char* ws; int ph_lo, ph_hi;
};

__device__ __forceinline__ float bflo(unsigned w) { return __uint_as_float(w << 16); }
__device__ __forceinline__ float bfhi(unsigned w) { return __uint_as_float(w & 0xffff0000u); }
__device__ __forceinline__ unsigned pk2(float lo, float hi) { return pg8::cvt_pk_bf16(lo, hi); }
__device__ __forceinline__ float shfl_xor_f(float v, int mask, int lane) { return __int_as_float(__builtin_amdgcn_ds_bpermute((lane ^ mask) << 2, __float_as_int(v))); }
__device__ __forceinline__ float shfl_idx_f(float v, int src) { return __int_as_float(__builtin_amdgcn_ds_bpermute(src << 2, __float_as_int(v))); }
__device__ __forceinline__ float wave_sum(float v, int lane) {
#pragma unroll
  for (int o = 32; o >= 1; o >>= 1) v += shfl_xor_f(v, o, lane); return v; }
__device__ __forceinline__ void wave_fence() { asm volatile("s_waitcnt lgkmcnt(0)" ::: "memory"); __builtin_amdgcn_wave_barrier(); }
__device__ __forceinline__ void st16_wt(void* p, u32x4 v) { asm volatile("global_store_dwordx4 %0, %1, off sc1\n\ts_nop 1" :: "v"(p), "v"(v) : "memory"); }
#define NTL(p) __builtin_nontemporal_load(p)
__device__ __forceinline__ void lds_barrier() { asm volatile("s_waitcnt lgkmcnt(0)" ::: "memory"); __builtin_amdgcn_s_barrier(); asm volatile("" ::: "memory"); }
__device__ __forceinline__ float sigmoidf_(float v) { return __builtin_amdgcn_rcpf(1.f + __expf(-v)); }

__device__ __forceinline__ void transpose_tile(const float* __restrict__ src, int N, bf16_t* __restrict__ dst, int ldd, int koff, int k0, int n0, float* tl, float scale = 1.0f) {
  const int tid = TIDX(), c = tid & 63, r = tid >> 6;
#pragma unroll
  for (int i = 0; i < 8; ++i) { const int k = r + 8 * i; tl[k * 65 + c] = NTL(src + (size_t)(k0 + k) * N + n0 + c) * scale; }
  lds_barrier();
  const int n = tid >> 3, kb = (tid & 7) * 8;
  u32x4 w;
  w.x = pk2(tl[(kb + 0) * 65 + n], tl[(kb + 1) * 65 + n]); w.y = pk2(tl[(kb + 2) * 65 + n], tl[(kb + 3) * 65 + n]);
  w.z = pk2(tl[(kb + 4) * 65 + n], tl[(kb + 5) * 65 + n]); w.w = pk2(tl[(kb + 6) * 65 + n], tl[(kb + 7) * 65 + n]);
  *(u32x4*)(dst + (size_t)(n0 + n) * ldd + koff + k0 + kb) = w;
  lds_barrier();
}
__device__ __forceinline__ void transpose_wide(const float* __restrict__ src, int N, bf16_t* __restrict__ dst, int ldd, int koff, int k0, int n0, float* tl) {
  const int tid = TIDX(), c4 = (tid & 63) * 4, r = tid >> 6;
  float4 v[8];
#pragma unroll
  for (int i = 0; i < 8; ++i) { const f32x4 q_ = NTL((const f32x4*)(src + (size_t)(k0 + r + 8 * i) * N + n0 + c4)); v[i] = make_float4(q_[0], q_[1], q_[2], q_[3]); }
#pragma unroll
  for (int i = 0; i < 8; ++i) *(float4*)(tl + (r + 8 * i) * 260 + c4) = v[i];
  lds_barrier();
  const int n = tid >> 1, kb = (tid & 1) * 32;
#pragma unroll
  for (int q = 0; q < 4; ++q) { const int kq = kb + q * 8; u32x4 w;
    w.x = pk2(tl[(kq + 0) * 260 + n], tl[(kq + 1) * 260 + n]); w.y = pk2(tl[(kq + 2) * 260 + n], tl[(kq + 3) * 260 + n]);
    w.z = pk2(tl[(kq + 4) * 260 + n], tl[(kq + 5) * 260 + n]); w.w = pk2(tl[(kq + 6) * 260 + n], tl[(kq + 7) * 260 + n]);
    *(u32x4*)(dst + (size_t)(n0 + n) * ldd + koff + k0 + kq) = w; }
  lds_barrier();
}
__device__ __forceinline__ void convert_win(const Params& p, int l, int item, float* tl) {
  transpose_wide(p.w_in + (size_t)l * 1024 * 9216, 9216, (bf16_t*)(p.ws + WS_WIN), 1024, 0, (item / 36) * 64, (item % 36) * 256, tl);
}
__device__ __forceinline__ void convert_small(const Params& p, int l, int item, float* tl) {
  unsigned char* base = p.ws + (size_t)l * SM_LAYER;
  if (item < 32) { transpose_wide(p.w_pa + (size_t)l * 512 * 1024, 1024, (bf16_t*)(base + OFF_WCAT), 1536, 0, (item >> 2) * 64, (item & 3) * 256, tl); }
  else if (item < 96) { const int it = item - 32; transpose_wide(p.w_pb + (size_t)l * 1024 * 1024, 1024, (bf16_t*)(base + OFF_WCAT), 1536, 512, (it >> 2) * 64, (it & 3) * 256, tl); }
  else if (item < 160) { const int it = item - 96; transpose_wide(p.w_o + (size_t)l * 1024 * 1024, 1024, (bf16_t*)(base + OFF_WO), 1024, 0, (it >> 2) * 64, (it & 3) * 256, tl); }
  else if (item < 176) { const int h = item - 160; transpose_tile(p.w_rg + (size_t)l * 65536 + h * 4096, 64, (bf16_t*)(base + OFF_WRG) + h * 4096, 64, 0, 0, 0, tl, -1.4426950408889634f); }
  else { const int h = item - 176; transpose_tile(p.w_ig + (size_t)l * 65536 + h * 4096, 64, (bf16_t*)(base + OFF_WIG) + h * 4096, 64, 0, 0, 0, tl, -1.4426950408889634f); }
}
__device__ __forceinline__ void mod_item(const Params& p, int l, int cgp, float* red) {
  const int tid = TIDX(), w = tid >> 6, lane = tid & 63;
  const float* W = p.w_mod + (size_t)l * 1024 * 3072;
  float* mod = (float*)(p.ws + WS_MOD);
  const int col = cgp * 64 + lane;
  float* sl = red + 1024;
#pragma unroll
  for (int q = 0; q < 4; ++q) { const float cv = p.c[tid + 512 * q]; sl[tid + 512 * q] = cv * sigmoidf_(cv); }
  __syncthreads();
  float a0 = 0.f, a1 = 0.f;
  for (int k0 = w * 128; k0 < w * 128 + 128; k0 += 16) {
    float wv[16];
#pragma unroll
    for (int e = 0; e < 16; ++e) wv[e] = NTL(W + (size_t)(k0 + e) * 3072 + col);
#pragma unroll
    for (int e = 0; e < 16; ++e) { a0 += sl[k0 + e] * wv[e]; a1 += sl[1024 + k0 + e] * wv[e]; }
  }
  red[(w * 2 + 0) * 64 + lane] = a0; red[(w * 2 + 1) * 64 + lane] = a1;
  __syncthreads();
  if (tid < 128) { const int b = tid >> 6; float s = 0.f;
#pragma unroll
    for (int ww = 0; ww < 8; ++ww) s += red[(ww * 2 + b) * 64 + lane];
    mod[(l * 2 + b) * 3072 + col] = s + p.b_mod[l * 3072 + col]; }
  __syncthreads();
}
__device__ __forceinline__ void prologue_phase(const Params& p, unsigned char* smem) {
  float* tl = (float*)smem;
  for (int it = BIDX(); it < 96 + 2 * 192 + 576; it += gridDim.x) {
    if (it < 576) convert_win(p, 0, it, tl);
    else if (it < 576 + 96) { const int j = it - 576; mod_item(p, j / 48, j % 48, tl); }
    else { const int j = it - 576 - 96; convert_small(p, j / 192, j % 192, tl); }
  }
}

__device__ __forceinline__ void prenorm_phase(const Params& p, const float* xsrc, int l) {
  const int lane = TIDX() & 63, nw = gridDim.x * 8;
  const float* gp = p.g_pre + l * 1024; const float* md = (const float*)(p.ws + WS_MOD) + l * 2 * 3072;
  bf16_t* h = (bf16_t*)(p.ws + WS_H);
  float4 gm[4], gs[4]; int bcur = -1;
  for (int row0 = (BIDX() * 8 + (TIDX() >> 6)) * 2; row0 < MTOK; row0 += nw * 2) {
    { const int b = row0 >> 13;
      if (b != bcur) { bcur = b;
#pragma unroll
        for (int i = 0; i < 4; ++i) { const int col = (lane + 64 * i) * 4;
          const float4 g = *(const float4*)(gp + col), sh = *(const float4*)(md + b * 3072 + col), sc = *(const float4*)(md + b * 3072 + 1024 + col);
          gm[i] = make_float4(g.x * (1.f + sc.x), g.y * (1.f + sc.y), g.z * (1.f + sc.z), g.w * (1.f + sc.w)); gs[i] = sh; } } }
    float4 v[2][4];
#pragma unroll
    for (int r = 0; r < 2; ++r) { const float4* xr = (const float4*)(xsrc + (size_t)(row0 + r) * 1024);
#pragma unroll
      for (int i = 0; i < 4; ++i) { const f32x4 q_ = NTL((const f32x4*)(xr + lane + 64 * i)); v[r][i] = make_float4(q_[0], q_[1], q_[2], q_[3]); } }
#pragma unroll
    for (int r = 0; r < 2; ++r) { const int row = row0 + r; float ss = 0.f;
#pragma unroll
      for (int i = 0; i < 4; ++i) ss += v[r][i].x * v[r][i].x + v[r][i].y * v[r][i].y + v[r][i].z * v[r][i].z + v[r][i].w * v[r][i].w;
      ss = wave_sum(ss, lane);
      const float rstd = rsqrtf(ss * (1.f / 1024.f) + 1e-6f);
#pragma unroll
      for (int i = 0; i < 4; ++i) { const int col = (lane + 64 * i) * 4; const float4 g = gm[i], sh = gs[i];
        u32x2 w; w.x = pk2(v[r][i].x * rstd * g.x + sh.x, v[r][i].y * rstd * g.y + sh.y);
        w.y = pk2(v[r][i].z * rstd * g.z + sh.z, v[r][i].w * rstd * g.w + sh.w);
        *(u32x2*)(h + (size_t)row * 1024 + col) = w; } }
  }
}

__device__ __forceinline__ float actf(float v, int act, float sc) { if (act == 0) return v * sc; const float r = sigmoidf_(v); return act == 1 ? v * r : r; }
template <int MODE> struct EpiT {
  static constexpr bool PERM = true, AFTER_DRAIN = false; static constexpr int MID_T = -1;
  unsigned char* ws;
  __device__ __forceinline__ void operator()(const f32x4 (&acc)[2][2][4][2], const pg8::Unit& u, int wr, int wc, int fr, int fq) const {
    bf16_t* dst; int ldc, pn0, act; float sc = 1.0f;
    if (MODE == 0) { if (u.pn < 18) { dst = (bf16_t*)(ws + WS_R); ldc = 4608; pn0 = 0; act = 0; if (u.pn < 6) sc = 0.08838834764831845f * 1.4426950408889634f; }
                     else { dst = (bf16_t*)(ws + WS_GATT); ldc = 512; pn0 = 18; act = 1; } }
    else if (MODE == 1) { if (u.pn < 4) { dst = (bf16_t*)(ws + WS_R); ldc = 1024; pn0 = 0; act = 0; }
                          else if (u.pn < 8) { dst = (bf16_t*)(ws + WS_R + 32 * MiB); ldc = 1024; pn0 = 4; act = 1; }
                          else { dst = (bf16_t*)(ws + WS_R + 64 * MiB); ldc = 2048; pn0 = 8; act = 2; } }
    else { dst = (bf16_t*)(ws + WS_R); ldc = 1024; pn0 = 0; act = 0; }
    asm volatile("" : "+v"(fr), "+v"(fq));
    const int row0 = u.pm * 256 + wr * 64 + fr, col0 = (u.pn - pn0) * 256 + wc * 32 + 8 * fq;
#pragma unroll
    for (int ai = 0; ai < 2; ++ai)
#pragma unroll
      for (int m = 0; m < 4; ++m) { bf16_t* rowp = dst + (size_t)(row0 + ai * 128 + m * 16) * ldc + col0;
#pragma unroll
        for (int bj = 0; bj < 2; ++bj) { const f32x4 v0 = acc[ai][bj][m][0], v1 = acc[ai][bj][m][1];
          u32x4 w; w.x = pk2(actf(v0[0], act, sc), actf(v0[1], act, sc)); w.y = pk2(actf(v0[2], act, sc), actf(v0[3], act, sc));
          w.z = pk2(actf(v1[0], act, sc), actf(v1[1], act, sc)); w.w = pk2(actf(v1[2], act, sc), actf(v1[3], act, sc));
          st16_wt(rowp + bj * 128, w); } }
  }
  __device__ __forceinline__ void mid(f32x4 (&)[2][2][4][2], const pg8::Unit&, int, int, int, int) const {}
};
struct EpiZ {
  static constexpr bool PERM = true, AFTER_DRAIN = false; static constexpr int MID_T = 8;
  const bf16_t* mg; bf16_t* z;
  __device__ __forceinline__ void mid(f32x4 (&acc)[2][2][4][2], const pg8::Unit& u, int wr, int wc, int fr, int fq) const {
    asm volatile("" : "+v"(fr), "+v"(fq));
    const int row0 = u.pm * 256 + wr * 64 + fr, col0 = u.pn * 256 + wc * 32 + 8 * fq;
#pragma unroll
    for (int ai = 0; ai < 2; ++ai)
#pragma unroll
      for (int mp = 0; mp < 2; ++mp) {
        u32x4 ga[2][2], gb[2][2];
#pragma unroll
        for (int mm = 0; mm < 2; ++mm) { const bf16_t* rp = mg + (size_t)(row0 + ai * 128 + (2 * mp + mm) * 16) * 2048 + col0;
#pragma unroll
          for (int bj = 0; bj < 2; ++bj) { ga[mm][bj] = NTL((const u32x4*)(rp + bj * 128)); gb[mm][bj] = NTL((const u32x4*)(rp + 1024 + bj * 128)); } }
#pragma unroll
        for (int mm = 0; mm < 2; ++mm)
#pragma unroll
          for (int bj = 0; bj < 2; ++bj) { const u32x4 a_ = ga[mm][bj], b_ = gb[mm][bj]; const int m = 2 * mp + mm;
            f32x4 r0, r1;
            r0[0] = bflo(a_.x) * __builtin_amdgcn_rcpf(bflo(b_.x)); r0[1] = bfhi(a_.x) * __builtin_amdgcn_rcpf(bfhi(b_.x));
            r0[2] = bflo(a_.y) * __builtin_amdgcn_rcpf(bflo(b_.y)); r0[3] = bfhi(a_.y) * __builtin_amdgcn_rcpf(bfhi(b_.y));
            r1[0] = bflo(a_.z) * __builtin_amdgcn_rcpf(bflo(b_.z)); r1[1] = bfhi(a_.z) * __builtin_amdgcn_rcpf(bfhi(b_.z));
            r1[2] = bflo(a_.w) * __builtin_amdgcn_rcpf(bflo(b_.w)); r1[3] = bfhi(a_.w) * __builtin_amdgcn_rcpf(bfhi(b_.w));
            acc[ai][bj][m][0] *= r0; acc[ai][bj][m][1] *= r1; }
        asm volatile("" ::: "memory"); __builtin_amdgcn_sched_barrier(0); }
  }
  __device__ __forceinline__ void operator()(const f32x4 (&acc)[2][2][4][2], const pg8::Unit& u, int wr, int wc, int fr, int fq) const {
    asm volatile("" : "+v"(fr), "+v"(fq));
    const int row0 = u.pm * 256 + wr * 64 + fr, col0 = u.pn * 256 + wc * 32 + 8 * fq;
#pragma unroll
    for (int ai = 0; ai < 2; ++ai) {
      u32x4 gb[4][2];
#pragma unroll
      for (int m = 0; m < 4; ++m)
#pragma unroll
        for (int bj = 0; bj < 2; ++bj) gb[m][bj] = NTL((const u32x4*)(mg + (size_t)(row0 + ai * 128 + m * 16) * 2048 + 1024 + col0 + bj * 128));
#pragma unroll
      for (int m = 0; m < 4; ++m) { const size_t ro = (size_t)(row0 + ai * 128 + m * 16);
#pragma unroll
        for (int bj = 0; bj < 2; ++bj) { const u32x4 g_ = gb[m][bj];
          const f32x4 v0 = acc[ai][bj][m][0], v1 = acc[ai][bj][m][1];
          u32x4 w; w.x = pk2(v0[0] * bflo(g_.x), v0[1] * bfhi(g_.x)); w.y = pk2(v0[2] * bflo(g_.y), v0[3] * bfhi(g_.y));
          w.z = pk2(v1[0] * bflo(g_.z), v1[1] * bfhi(g_.z)); w.w = pk2(v1[2] * bflo(g_.w), v1[3] * bfhi(g_.w));
          *(u32x4*)(z + ro * 1024 + col0 + bj * 128) = w; } }
      asm volatile("" ::: "memory"); }
  }
};

struct AttnItem { int g, hh, dil, n; size_t tokbase; };
__device__ __forceinline__ AttnItem attn_decode(int item) {
  AttnItem a; const int blk = item & 63, bg = item >> 8; a.hh = (item >> 6) & 3; a.g = bg % 3; const int b = bg / 3;
  const int dsh = 2 * a.g, nb = 64 >> dsh; a.dil = 1 << dsh; const int r = blk / nb; a.n = blk % nb; a.tokbase = (size_t)b * SEQ + r; return a;
}
__device__ __forceinline__ void attn_load(const bf16_t* qkv, const AttnItem& a, int tid, int w, int l15, int g4, u32x4 (&kr)[8], u32x4 (&vr)[8], bf16x8 (&qf)[4]) {
  const bf16_t* qp = qkv + a.g * 512 + a.hh * 128; const bf16_t* kp = qp + 1536; const bf16_t* vp = qp + 3072;
  const size_t tq = a.tokbase + (size_t)a.dil * (a.n * 128 + 16 * w + l15);
#pragma unroll
  for (int kk = 0; kk < 4; ++kk) qf[kk] = NTL((const bf16x8*)(qp + tq * 4608 + 32 * kk + 8 * g4));
  const bool odd = a.n & 1;
#pragma unroll
  for (int it = 0; it < 8; ++it) { if (odd && it >= 4) break;
    const int cid = it * 512 + tid, row = cid >> 4, ch = cid & 15;
    int idx = (odd ? a.n : a.n - 1) * 128 + row; if (idx < 0) idx = 0;
    const size_t tk = a.tokbase + (size_t)a.dil * idx;
    kr[it] = *(const u32x4*)(kp + tk * 4608 + ch * 8); vr[it] = *(const u32x4*)(vp + tk * 4608 + ch * 8); }
}
__device__ __forceinline__ void attn_phase(const Params& p, unsigned char* smem) {
  LAS unsigned char* lds = (LAS unsigned char*)smem;
  const int tid = TIDX(), lane = tid & 63, w = tid >> 6, g4 = lane >> 4, l15 = lane & 15;
  constexpr int KSTR = 272, VOFF = 256 * 272, VSTR = 288;
  for (int i = tid; i < 16 * VSTR / 4; i += 512) ((LAS unsigned*)(lds + VOFF + 256 * VSTR))[i] = 0u;
  const bf16_t* qkv = (const bf16_t*)(p.ws + WS_R);
  bf16_t* acat = (bf16_t*)(p.ws + WS_ACAT);
  float* mbuf = (float*)(p.ws + WS_ML); float* lbuf = mbuf + 3 * MTOK * 4;
  const int G = gridDim.x;
  int vb = BIDX();
  if (G == 256) vb = (vb & 7) * 32 + (vb >> 3);
  const int nsteps = (vb < 768) ? 2 * ((768 - vb + G - 1) / G) : 0;
  u32x4 kr[8], vr[8]; bf16x8 qn[4];
  u32x2 opk[8]; bf16_t* op_pend = acat; size_t ml_pend = 0; float mx_pend = 0.f, l_pend = 0.f;
  if (nsteps > 0) { const AttnItem a0 = attn_decode(2 * vb); attn_load(qkv, a0, tid, w, l15, g4, kr, vr, qn); }
  for (int s = 0; s < nsteps; ++s) {
    const int item = 2 * (vb + (s >> 1) * G) + (s & 1);
    const AttnItem a = attn_decode(item);
    const int g = a.g, hh = a.hh, dil = a.dil, n = a.n; const size_t tokbase = a.tokbase;
    const int rot = (s & 1) ? 128 : 0;
    lds_barrier();
#pragma unroll
    for (int it = 0; it < 8; ++it) { if ((s & 1) && it >= 4) break;
      const int cid = it * 512 + tid, row = cid >> 4, ch = cid & 15;
      *(LAS u32x4*)(lds + row * KSTR + ch * 16) = kr[it]; *(LAS u32x4*)(lds + VOFF + row * VSTR + ch * 16) = vr[it]; }
    bf16x8 qf[4];
#pragma unroll
    for (int kk = 0; kk < 4; ++kk) qf[kk] = qn[kk];
    lds_barrier();
    if (s > 0) {
#pragma unroll
      for (int dt = 0; dt < 8; ++dt) *(u32x2*)(op_pend + 16 * dt) = opk[dt];
      if (g4 == 0) { mbuf[ml_pend] = mx_pend; lbuf[ml_pend] = l_pend; } }
    if (s + 1 < nsteps) { const AttnItem an = attn_decode(2 * (vb + ((s + 1) >> 1) * G) + ((s + 1) & 1)); attn_load(qkv, an, tid, w, l15, g4, kr, vr, qn); }
    f32x4 S[9];
    { bf16x8 kc[4], kn[4];
#pragma unroll
      for (int kk = 0; kk < 4; ++kk) kc[kk] = *(const LAS bf16x8*)(lds + ((16 * w + l15) ^ rot) * KSTR + 64 * kk + 16 * g4);
#pragma unroll
      for (int T = 0; T < 9; ++T) {
        if (T < 8) {
#pragma unroll
          for (int kk = 0; kk < 4; ++kk) kn[kk] = *(const LAS bf16x8*)(lds + ((16 * (w + T + 1) + l15) ^ rot) * KSTR + 64 * kk + 16 * g4); }
        __builtin_amdgcn_sched_barrier(0);
        f32x4 a_ = {0.f, 0.f, 0.f, 0.f};
#pragma unroll
        for (int kk = 0; kk < 4; ++kk) a_ = __builtin_amdgcn_mfma_f32_16x16x32_bf16(kc[kk], qf[kk], a_, 0, 0, 0);
        S[T] = a_;
        __builtin_amdgcn_sched_barrier(0);
#pragma unroll
        for (int kk = 0; kk < 4; ++kk) kc[kk] = kn[kk]; } }
    float mx = -1e30f;
    if (n > 0) {
#pragma unroll
      for (int jj = 0; jj < 4; ++jj) { const int d0 = 4 * g4 + jj - l15; if (d0 < 0) S[0][jj] = -1e30f; if (d0 > 0) S[8][jj] = -1e30f; }
#pragma unroll
      for (int T = 0; T < 9; ++T)
#pragma unroll
        for (int jj = 0; jj < 4; ++jj) mx = fmaxf(mx, S[T][jj]);
    } else {
#pragma unroll
      for (int T = 0; T < 9; ++T)
#pragma unroll
        for (int jj = 0; jj < 4; ++jj) { const int dj = 16 * T + 4 * g4 + jj - l15, j = 16 * (w + T) + 4 * g4 + jj;
          const bool valid = (dj >= 0) && (dj <= 128) && (j >= 128);
          const float sv = valid ? S[T][jj] : -1e30f; S[T][jj] = sv; mx = fmaxf(mx, sv); }
    }
    mx = fmaxf(mx, shfl_xor_f(mx, 16, lane)); mx = fmaxf(mx, shfl_xor_f(mx, 32, lane));
    float lsum = 0.f;
#pragma unroll
    for (int T = 0; T < 9; ++T)
#pragma unroll
      for (int jj = 0; jj < 4; ++jj) { const float pv = __builtin_amdgcn_exp2f(S[T][jj] - mx); S[T][jj] = pv; lsum += pv; }
    lsum += shfl_xor_f(lsum, 16, lane); lsum += shfl_xor_f(lsum, 32, lane);
    f32x4 O[8];
#pragma unroll
    for (int dt = 0; dt < 8; ++dt) O[dt] = (f32x4){0.f, 0.f, 0.f, 0.f};
#pragma unroll
    for (int s5 = 0; s5 < 5; ++s5) { const int T0 = 2 * s5, T1 = 2 * s5 + 1;
      u32x4 pw; pw.x = pk2(S[T0][0], S[T0][1]); pw.y = pk2(S[T0][2], S[T0][3]);
      if (T1 < 9) { pw.z = pk2(S[T1 < 9 ? T1 : 0][0], S[T1 < 9 ? T1 : 0][1]); pw.w = pk2(S[T1 < 9 ? T1 : 0][2], S[T1 < 9 ? T1 : 0][3]); } else { pw.z = 0u; pw.w = 0u; }
      const bf16x8 pf = __builtin_bit_cast(bf16x8, pw);
      const int ra = (16 * (w + T0) + 4 * g4 + (l15 >> 2)) ^ rot;
      int rb = 16 * (w + T1) + 4 * g4 + (l15 >> 2); if (rb < 256) rb ^= rot;
      v4i16_t vA[8], vB[8];
#pragma unroll
      for (int dt = 0; dt < 8; ++dt) { const int cb = (16 * dt + 4 * (l15 & 3)) * 2;
        vA[dt] = __builtin_amdgcn_ds_read_tr16_b64_v4i16((LAS v4i16_t*)(lds + VOFF + ra * VSTR + cb));
        vB[dt] = __builtin_amdgcn_ds_read_tr16_b64_v4i16((LAS v4i16_t*)(lds + VOFF + rb * VSTR + cb)); }
      __builtin_amdgcn_sched_barrier(0);
#pragma unroll
      for (int dt = 0; dt < 8; ++dt) { const v4i16_t va = vA[dt], vb_ = vB[dt];
        bf16x8 vf; vf[0] = va[0]; vf[1] = va[1]; vf[2] = va[2]; vf[3] = va[3]; vf[4] = vb_[0]; vf[5] = vb_[1]; vf[6] = vb_[2]; vf[7] = vb_[3];
        O[dt] = __builtin_amdgcn_mfma_f32_16x16x32_bf16(vf, pf, O[dt], 0, 0, 0); }
      __builtin_amdgcn_sched_barrier(0); }
    { const float inv = 1.0f / lsum;
      const size_t t = tokbase + (size_t)dil * (n * 128 + 16 * w + l15);
      op_pend = acat + t * 1536 + g * 512 + hh * 128 + 4 * g4; ml_pend = ((size_t)g * MTOK + t) * 4 + hh; mx_pend = mx; l_pend = lsum;
#pragma unroll
      for (int dt = 0; dt < 8; ++dt) { opk[dt].x = pk2(O[dt][0] * inv, O[dt][1] * inv); opk[dt].y = pk2(O[dt][2] * inv, O[dt][3] * inv); } }
  }
  if (nsteps > 0) {
#pragma unroll
    for (int dt = 0; dt < 8; ++dt) *(u32x2*)(op_pend + 16 * dt) = opk[dt];
    if (g4 == 0) { mbuf[ml_pend] = mx_pend; lbuf[ml_pend] = l_pend; } }
}

__device__ __forceinline__ void mix_phase(const Params& p) {
  const int lane = TIDX() & 63, nw = gridDim.x * 8, c = lane * 8, j = lane >> 4;
  bf16_t* acat = (bf16_t*)(p.ws + WS_ACAT); const bf16_t* gatt = (const bf16_t*)(p.ws + WS_GATT);
  const float* mbuf = (const float*)(p.ws + WS_ML); const float* lbuf = mbuf + 3 * MTOK * 4;
  for (int t = BIDX() * 8 + (TIDX() >> 6); t < MTOK; t += nw) {
    const float m0 = mbuf[((size_t)0 * MTOK + t) * 4 + j], m1 = mbuf[((size_t)1 * MTOK + t) * 4 + j], m2 = mbuf[((size_t)2 * MTOK + t) * 4 + j];
    const float l0 = lbuf[((size_t)0 * MTOK + t) * 4 + j], l1 = lbuf[((size_t)1 * MTOK + t) * 4 + j], l2 = lbuf[((size_t)2 * MTOK + t) * 4 + j];
    const float mm = fmaxf(m0, fmaxf(m1, m2));
    float w0 = l0 * __builtin_amdgcn_exp2f(m0 - mm), w1 = l1 * __builtin_amdgcn_exp2f(m1 - mm), w2 = l2 * __builtin_amdgcn_exp2f(m2 - mm);
    const float inv = 1.0f / (w0 + w1 + w2); w0 *= inv; w1 *= inv; w2 *= inv;
    bf16_t* ap = acat + (size_t)t * 1536 + c;
    const u32x4 o0 = NTL((const u32x4*)ap), o1 = NTL((const u32x4*)(ap + 512)), o2 = NTL((const u32x4*)(ap + 1024)), ga = NTL((const u32x4*)(gatt + (size_t)t * 512 + c));
    u32x4 r;
    r.x = pk2((w0 * bflo(o0.x) + w1 * bflo(o1.x) + w2 * bflo(o2.x)) * bflo(ga.x), (w0 * bfhi(o0.x) + w1 * bfhi(o1.x) + w2 * bfhi(o2.x)) * bfhi(ga.x));
    r.y = pk2((w0 * bflo(o0.y) + w1 * bflo(o1.y) + w2 * bflo(o2.y)) * bflo(ga.y), (w0 * bfhi(o0.y) + w1 * bfhi(o1.y) + w2 * bfhi(o2.y)) * bfhi(ga.y));
    r.z = pk2((w0 * bflo(o0.z) + w1 * bflo(o1.z) + w2 * bflo(o2.z)) * bflo(ga.z), (w0 * bfhi(o0.z) + w1 * bfhi(o1.z) + w2 * bfhi(o2.z)) * bfhi(ga.z));
    r.w = pk2((w0 * bflo(o0.w) + w1 * bflo(o1.w) + w2 * bflo(o2.w)) * bflo(ga.w), (w0 * bfhi(o0.w) + w1 * bfhi(o1.w) + w2 * bfhi(o2.w)) * bfhi(ga.w));
    *(u32x4*)ap = r;
  }
}

__device__ __forceinline__ void lru_load_rows(const bf16_t* ub, size_t t0, int sbase, int tt, int chc, u32x4 (&ua)[4], u32x4 (&uv)[4]) {
#pragma unroll
  for (int j = 0; j < 4; ++j) { ua[j] = (u32x4){0u, 0u, 0u, 0u}; uv[j] = (u32x4){0u, 0u, 0u, 0u};
    if (sbase + tt - j >= 0) { const bf16_t* up = ub + (t0 + tt - j) * 1024 + chc; ua[j] = *(const u32x4*)up; uv[j] = *(const u32x4*)(up + 8); } }
}
__device__ __forceinline__ void lru_pass2(const Params& p, int l, unsigned char* smem, int vb) {
  const int tid = TIDX(), lane = tid & 63, w = tid >> 6;
  LAS float* Uc = (LAS float*)((LAS unsigned char*)smem + w * 4352);
  const unsigned* labuf = (const unsigned*)(p.ws + WS_H); const unsigned* xibuf = (const unsigned*)(p.ws + WS_R + 128 * MiB);
  const bf16_t* glru = (const bf16_t*)(p.ws + WS_R + 32 * MiB);
  bf16_t* acat = (bf16_t*)(p.ws + WS_ACAT);
  float* aggA = (float*)(p.ws + WS_AGG); float* aggH = aggA + 2 * 64 * 1024;
  const int tt = lane >> 2, c16 = (lane & 3) * 16;
  {
    const int hb = vb & 15, grp = vb >> 4, idx = grp * 8 + w, piece = idx & 63, b = idx >> 6;
    const int ch = hb * 64 + lane, chc = hb * 64 + c16;
    const unsigned* lap = labuf + (size_t)(idx * 16 + hb) * 4096 + lane; const unsigned* xip = xibuf + (size_t)(idx * 16 + hb) * 4096 + lane;
    unsigned lw[8], xw[8];
#pragma unroll
    for (int e = 0; e < 8; ++e) { lw[e] = NTL(lap + e * 64); xw[e] = NTL(xip + e * 64); }
    float hc = 0.f;
    {
      unsigned* flags = (unsigned*)(p.ws + WS_FLAG) + l * 256; const int g0 = 8 * b, nwait = grp - g0;
      unsigned spins = 0;
      for (;;) { const unsigned f = (lane < nwait) ? __hip_atomic_load(flags + hb + 16 * (g0 + lane), __ATOMIC_RELAXED, __HIP_MEMORY_SCOPE_AGENT) : 1u;
        if (__builtin_amdgcn_ballot_w64(f == 0u) == 0ull) break;
        if (++spins > (1u << 22)) break;
        __builtin_amdgcn_s_sleep(2); } }
    { float av[8], hv8[8];
#pragma unroll
      for (int e = 0; e < 8; ++e) { const bool ok = 8 * b + e < grp; const size_t o = (size_t)(ok ? 8 * b + e : grp) * 1024 + ch;
        const float a_ = ok ? __hip_atomic_load(aggA + o, __ATOMIC_RELAXED, __HIP_MEMORY_SCOPE_AGENT) : 1.f, h_ = ok ? __hip_atomic_load(aggH + o, __ATOMIC_RELAXED, __HIP_MEMORY_SCOPE_AGENT) : 0.f; av[e] = a_; hv8[e] = h_; }
#pragma unroll
      for (int e = 0; e < 8; ++e) hc = av[e] * hc + hv8[e];
      const LAS float* blk = (const LAS float*)((LAS unsigned char*)smem + 8 * 14848 + 18432);
      for (int q = 0; q < w; ++q) hc = blk[q * 64 + lane] * hc + blk[512 + q * 64 + lane]; }
    for (int sub = 0; sub < 8; ++sub) {
      const size_t t0 = (size_t)b * SEQ + piece * 128 + sub * 16;
      const bf16_t* gp = glru + (t0 + tt) * 1024 + chc; const u32x4 ga = NTL((const u32x4*)gp), gv = NTL((const u32x4*)(gp + 8));
      unsigned lc[8], xc[8];
#pragma unroll
      for (int e = 0; e < 8; ++e) { lc[e] = lw[e]; xc[e] = xw[e]; }
      if (sub < 7) {
#pragma unroll
        for (int e = 0; e < 8; ++e) { lw[e] = NTL(lap + ((sub + 1) * 8 + e) * 64); xw[e] = NTL(xip + ((sub + 1) * 8 + e) * 64); } }
#pragma unroll
      for (int e = 0; e < 8; ++e) {
        hc = __builtin_amdgcn_exp2f(bflo(lc[e])) * hc + bflo(xc[e]); Uc[(2 * e) * 65 + lane] = hc;
        hc = __builtin_amdgcn_exp2f(bfhi(lc[e])) * hc + bfhi(xc[e]); Uc[(2 * e + 1) * 65 + lane] = hc; }
      wave_fence();
      float hv[16];
#pragma unroll
      for (int e = 0; e < 16; ++e) hv[e] = Uc[tt * 65 + c16 + e];
      u32x4 o0, o1;
      o0.x = pk2(hv[0] * bflo(ga.x), hv[1] * bfhi(ga.x)); o0.y = pk2(hv[2] * bflo(ga.y), hv[3] * bfhi(ga.y)); o0.z = pk2(hv[4] * bflo(ga.z), hv[5] * bfhi(ga.z)); o0.w = pk2(hv[6] * bflo(ga.w), hv[7] * bfhi(ga.w));
      o1.x = pk2(hv[8] * bflo(gv.x), hv[9] * bfhi(gv.x)); o1.y = pk2(hv[10] * bflo(gv.y), hv[11] * bfhi(gv.y)); o1.z = pk2(hv[12] * bflo(gv.z), hv[13] * bfhi(gv.z)); o1.w = pk2(hv[14] * bflo(gv.w), hv[15] * bfhi(gv.w));
      bf16_t* op = acat + (t0 + tt) * 1536 + 512 + chc;
      *(u32x4*)op = o0; *(u32x4*)(op + 8) = o1;
      wave_fence();
    }
  }
}

__device__ __forceinline__ void lru_load_rows4(const bf16_t* ub, size_t t0, int sbase, int tq, int chc4, u32x2 (&ur)[7]) {
#pragma unroll
  for (int rho = 0; rho < 7; ++rho) { ur[rho] = (u32x2){0u, 0u};
    if (sbase + 4 * tq - 3 + rho >= 0) ur[rho] = *(const u32x2*)(ub + (t0 + 4 * tq + rho - 3) * 1024 + chc4); }
}
__device__ __forceinline__ void lru_conv4(float (&uc)[4][4], const float4 cb, const float4 (&w)[4], const u32x2 (&ur)[7]) {
#pragma unroll
  for (int k = 0; k < 4; ++k) { uc[k][0] = cb.x; uc[k][1] = cb.y; uc[k][2] = cb.z; uc[k][3] = cb.w;
#pragma unroll
    for (int j = 0; j < 4; ++j) { const u32x2 r = ur[k - j + 3];
      uc[k][0] += w[j].x * bflo(r.x); uc[k][1] += w[j].y * bfhi(r.x); uc[k][2] += w[j].z * bflo(r.y); uc[k][3] += w[j].w * bfhi(r.y); } }
}
__device__ __forceinline__ void lru_pass1(const Params& p, int l, unsigned char* smem) {
  const int tid = TIDX(), lane = tid & 63, w = tid >> 6, g4 = lane >> 4, l15 = lane & 15;
  constexpr int WOFF = 8 * 14848;
  LAS unsigned char* base = (LAS unsigned char*)smem;
  LAS unsigned char* my = base + w * 14848;
  LAS float* Uc = (LAS float*)(my + 2304); LAS float* Rp = (LAS float*)(my + 6464); LAS float* Ip = (LAS float*)(my + 10624);
  const bf16_t* ub = (const bf16_t*)(p.ws + WS_R);
  unsigned* labuf = (unsigned*)(p.ws + WS_H); unsigned* xibuf = (unsigned*)(p.ws + WS_R + 128 * MiB);
  float* aggA = (float*)(p.ws + WS_AGG); float* aggH = aggA + 2 * 64 * 1024;
  const int tq = lane >> 4, c4 = (lane & 15) * 4;
  for (int vb = BIDX(); vb < 256; vb += gridDim.x) {
    const int hb = vb & 15, idx = (vb >> 4) * 8 + w, piece = idx & 63, b = idx >> 6;
    __syncthreads();
    { const bf16_t* WrgT = (const bf16_t*)(p.ws + (size_t)l * SM_LAYER + OFF_WRG) + hb * 4096; const bf16_t* WigT = (const bf16_t*)(p.ws + (size_t)l * SM_LAYER + OFF_WIG) + hb * 4096;
      const int row = tid >> 3, ch8 = (tid & 7) * 8;
      *(LAS u32x4*)(base + WOFF + row * 144 + ch8 * 2) = *(const u32x4*)(WrgT + row * 64 + ch8);
      *(LAS u32x4*)(base + WOFF + 9216 + row * 144 + ch8 * 2) = *(const u32x4*)(WigT + row * 64 + ch8); }
    __syncthreads();
    const int ch = hb * 64 + lane, chc4 = hb * 64 + c4;
    const float brg = -1.4426950408889634f * p.b_rg[l * 1024 + ch], big = -1.4426950408889634f * p.b_ig[l * 1024 + ch];
    const float sp = -8.0f * 1.4426950408889634f * log1pf(expf(-p.lam[l * 1024 + ch]));
    float hc = 0.f, Lsum = 0.f;
    unsigned* lap = labuf + (size_t)(idx * 16 + hb) * 4096 + lane; unsigned* xip = xibuf + (size_t)(idx * 16 + hb) * 4096 + lane;
    const float4 cvb = *(const float4*)(p.conv_b + l * 1024 + chc4); float4 cvw[4];
#pragma unroll
    for (int j = 0; j < 4; ++j) cvw[j] = *(const float4*)(p.conv_w + (size_t)(l * 4 + j) * 1024 + chc4);
    bf16x8 wrg[4][2], wig[4][2];
#pragma unroll
    for (int nt = 0; nt < 4; ++nt)
#pragma unroll
      for (int kk = 0; kk < 2; ++kk) { const int wo = WOFF + (16 * nt + l15) * 144 + (32 * kk + 8 * g4) * 2;
        wrg[nt][kk] = *(const LAS bf16x8*)(base + wo); wig[nt][kk] = *(const LAS bf16x8*)(base + wo + 9216); }
    u32x2 ur0[7], ur1[7];
    lru_load_rows4(ub, (size_t)b * SEQ + piece * 128, piece * 128, tq, chc4, ur0);
    lru_load_rows4(ub, (size_t)b * SEQ + piece * 128 + 16, piece * 128 + 16, tq, chc4, ur1);
    for (int sub = 0; sub < 8; ++sub) {
      const int sbase = piece * 128 + sub * 16;
      const size_t t0 = (size_t)b * SEQ + sbase;
      float uc[4][4];
      if (sub & 1) { lru_conv4(uc, cvb, cvw, ur1); if (sub + 2 < 8) lru_load_rows4(ub, t0 + 32, sbase + 32, tq, chc4, ur1); }
      else { lru_conv4(uc, cvb, cvw, ur0); if (sub + 2 < 8) lru_load_rows4(ub, t0 + 32, sbase + 32, tq, chc4, ur0); }
#pragma unroll
      for (int k = 0; k < 4; ++k) { u32x2 a_; a_.x = pk2(uc[k][0], uc[k][1]); a_.y = pk2(uc[k][2], uc[k][3]);
        *(LAS u32x2*)(my + (4 * tq + k) * 144 + c4 * 2) = a_;
#pragma unroll
        for (int e = 0; e < 4; ++e) Uc[(4 * tq + k) * 65 + c4 + e] = uc[k][e]; }
      wave_fence();
      { bf16x8 af[2];
#pragma unroll
        for (int kk = 0; kk < 2; ++kk) af[kk] = *(const LAS bf16x8*)(my + l15 * 144 + (32 * kk + 8 * g4) * 2);
#pragma unroll
        for (int nt = 0; nt < 4; ++nt) { f32x4 ar = {0.f, 0.f, 0.f, 0.f}, ai = {0.f, 0.f, 0.f, 0.f};
#pragma unroll
          for (int kk = 0; kk < 2; ++kk) { ar = __builtin_amdgcn_mfma_f32_16x16x32_bf16(af[kk], wrg[nt][kk], ar, 0, 0, 0); ai = __builtin_amdgcn_mfma_f32_16x16x32_bf16(af[kk], wig[nt][kk], ai, 0, 0, 0); }
#pragma unroll
          for (int jj = 0; jj < 4; ++jj) { Rp[(4 * g4 + jj) * 65 + 16 * nt + l15] = ar[jj]; Ip[(4 * g4 + jj) * 65 + 16 * nt + l15] = ai[jj]; } } }
      wave_fence();
#pragma unroll
      for (int t2 = 0; t2 < 16; t2 += 2) {
        float lav[2], xiv[2];
#pragma unroll
        for (int q = 0; q < 2; ++q) {
          const float e1 = __builtin_amdgcn_exp2f(Rp[(t2 + q) * 65 + lane] + brg), e2 = __builtin_amdgcn_exp2f(Ip[(t2 + q) * 65 + lane] + big), uu = Uc[(t2 + q) * 65 + lane];
          const float inv = __builtin_amdgcn_rcpf((1.f + e1) * (1.f + e2));
          const float rg = (1.f + e2) * inv, ig = (1.f + e1) * inv;
          const float la = bflo(pk2(sp * rg, 0.f)), a = __builtin_amdgcn_exp2f(la);
          const float xin = bflo(pk2(__builtin_amdgcn_sqrtf(1.f - a * a) * (ig * uu), 0.f));
          hc = a * hc + xin; Lsum += la; lav[q] = la; xiv[q] = xin; }
        lap[(sub * 8 + (t2 >> 1)) * 64] = pk2(lav[0], lav[1]); xip[(sub * 8 + (t2 >> 1)) * 64] = pk2(xiv[0], xiv[1]);
      }
      wave_fence();
    }
    { LAS float* blk = (LAS float*)(base + WOFF + 18432);
      blk[w * 64 + lane] = __builtin_amdgcn_exp2f(Lsum); blk[512 + w * 64 + lane] = hc;
      __syncthreads();
      if (w == 0) {
        float A8 = 1.f, H8 = 0.f;
#pragma unroll
        for (int q = 0; q < 8; ++q) { const float a_ = blk[q * 64 + lane], h_ = blk[512 + q * 64 + lane]; H8 = a_ * H8 + h_; A8 *= a_; }
        const int grp = vb >> 4;
        __hip_atomic_store(aggA + (size_t)grp * 1024 + ch, A8, __ATOMIC_RELAXED, __HIP_MEMORY_SCOPE_AGENT);
        __hip_atomic_store(aggH + (size_t)grp * 1024 + ch, H8, __ATOMIC_RELAXED, __HIP_MEMORY_SCOPE_AGENT);
        asm volatile("s_waitcnt vmcnt(0)" ::: "memory");
        if (lane == 0) __hip_atomic_store((unsigned*)(p.ws + WS_FLAG) + l * 256 + vb, 1u, __ATOMIC_RELAXED, __HIP_MEMORY_SCOPE_AGENT); } }
    lru_pass2(p, l, smem, vb);
  }
}
__device__ __forceinline__ void post_phase(const Params& p, int l, const float* xold, float* xnew, bool make_h) {
  const int lane = TIDX() & 63, nw = gridDim.x * 8;
  const bf16_t* ob = (const bf16_t*)(p.ws + WS_R);
  const float* gpo = p.g_post + l * 1024; const float* md = (const float*)(p.ws + WS_MOD) + l * 2 * 3072;
  const float* gpn = p.g_pre + (l + 1) * 1024; const float* mdn = md + 2 * 3072;
  bf16_t* h = (bf16_t*)(p.ws + WS_H);
  float4 gg[4], gm[4], gs[4]; int bcur = -1;
  for (int row0 = (BIDX() * 8 + (TIDX() >> 6)) * 2; row0 < MTOK; row0 += nw * 2) {
    { const int b = row0 >> 13;
      if (b != bcur) { bcur = b;
#pragma unroll
        for (int i = 0; i < 4; ++i) { const int col = (lane + 64 * i) * 4;
          const float4 g = *(const float4*)(gpo + col), gt = *(const float4*)(md + b * 3072 + 2048 + col); gg[i] = make_float4(g.x * gt.x, g.y * gt.y, g.z * gt.z, g.w * gt.w);
          if (make_h) { const float4 gn = *(const float4*)(gpn + col), sh = *(const float4*)(mdn + b * 3072 + col), sc = *(const float4*)(mdn + b * 3072 + 1024 + col);
            gm[i] = make_float4(gn.x * (1.f + sc.x), gn.y * (1.f + sc.y), gn.z * (1.f + sc.z), gn.w * (1.f + sc.w)); gs[i] = sh; } } } }
    u32x2 ow[2][4]; float4 xv[2][4];
#pragma unroll
    for (int r = 0; r < 2; ++r)
#pragma unroll
      for (int i = 0; i < 4; ++i) { ow[r][i] = NTL((const u32x2*)(ob + (size_t)(row0 + r) * 1024 + (lane + 64 * i) * 4)); { const f32x4 q_ = NTL((const f32x4*)(xold + (size_t)(row0 + r) * 1024 + (lane + 64 * i) * 4)); xv[r][i] = make_float4(q_[0], q_[1], q_[2], q_[3]); } }
#pragma unroll
    for (int r = 0; r < 2; ++r) { const int row = row0 + r;
      float4 o[4]; float ss = 0.f;
#pragma unroll
      for (int i = 0; i < 4; ++i) { o[i] = make_float4(bflo(ow[r][i].x), bfhi(ow[r][i].x), bflo(ow[r][i].y), bfhi(ow[r][i].y)); ss += o[i].x * o[i].x + o[i].y * o[i].y + o[i].z * o[i].z + o[i].w * o[i].w; }
      ss = wave_sum(ss, lane);
      const float rstd = rsqrtf(ss * (1.f / 1024.f) + 1e-6f);
      float4 y[4]; float s2 = 0.f;
#pragma unroll
      for (int i = 0; i < 4; ++i) { const int col = (lane + 64 * i) * 4;
        const float4 xq = xv[r][i], g = gg[i];
        y[i].x = xq.x + g.x * (o[i].x * rstd); y[i].y = xq.y + g.y * (o[i].y * rstd); y[i].z = xq.z + g.z * (o[i].z * rstd); y[i].w = xq.w + g.w * (o[i].w * rstd);
        *(float4*)(xnew + (size_t)row * 1024 + col) = y[i];
        s2 += y[i].x * y[i].x + y[i].y * y[i].y + y[i].z * y[i].z + y[i].w * y[i].w; }
      if (make_h) {
        s2 = wave_sum(s2, lane);
        const float r2 = rsqrtf(s2 * (1.f / 1024.f) + 1e-6f);
#pragma unroll
        for (int i = 0; i < 4; ++i) { const int col = (lane + 64 * i) * 4;
          const float4 g = gm[i], sh = gs[i];
          u32x2 w; w.x = pk2(y[i].x * r2 * g.x + sh.x, y[i].y * r2 * g.y + sh.y);
          w.y = pk2(y[i].z * r2 * g.z + sh.z, y[i].w * r2 * g.w + sh.w);
          *(u32x2*)(h + (size_t)row * 1024 + col) = w; }
      } }
  }
}

#ifndef REP_K
#define REP_K -1
#endif
#ifndef TS_K
#define TS_K -1
#endif
__global__ void __launch_bounds__(512, 2) hybrid_fwd(Params p) {
  extern __shared__ __attribute__((aligned(16))) unsigned char smem[];
  cg::grid_group grid = cg::this_grid();
  PG8_LAS unsigned char* lds = (PG8_LAS unsigned char*)smem;
  if (threadIdx.x < 4) ((PG8_LAS unsigned*)(lds + LDS_MAIN))[threadIdx.x] = 0u;
  __syncthreads();
  XcdBarrier xbar = xcd_barrier_post((unsigned*)(p.ws + WS_BAR), (volatile XLAS unsigned*)(lds + LDS_MAIN));
#define GRID_BAR() do { if (p.ph_hi > 1000) grid.sync(); else xcd_barrier(xbar); } while (0)
  for (int ph = p.ph_lo; ph < p.ph_hi; ++ph) {
    const int nrep = ((REP_K >= 0 && REP_K < 8 && ph >= 2 && (ph - 2) % 7 == REP_K) || (REP_K == 8 && ph == 9) || (REP_K == 200 && ph == 0) || (REP_K == 201 && ph == 1)) ? 2 : 1;
#if TS_K >= 0
    if (blockIdx.x == 0 && threadIdx.x == 0) ((unsigned long long*)(p.ws + WS_BAR + 14336))[ph] = __builtin_amdgcn_s_memrealtime();
#endif
    for (int rep = 0; rep < nrep; ++rep) {
    if (rep > 0) GRID_BAR();
    if (ph == 0) prologue_phase(p, smem);
    else if (ph == 1) prenorm_phase(p, p.x, 0);
    else {
      const int l = (ph - 2) / 7, k = (ph - 2) % 7;
      bf16_t* R = (bf16_t*)(p.ws + WS_R);
      if (k == 0) {
        pg8::Gemm g; g.A = (const bf16_t*)(p.ws + WS_H); g.Bt = (const bf16_t*)(p.ws + WS_WIN); g.M = MTOK; g.N = 5120; g.K = 1024;
        EpiT<0> E; E.ws = p.ws; pg8::StaticOrder S; S.init(g.M, g.N, (int)gridDim.x, (int)BIDX());
        pg8::gemm_phase<EpiT<0>, pg8::StaticOrder, false>(lds, g, S, E, nullptr);
      } else if (k == 2) {
        mix_phase(p);
        pg8::Gemm g; g.A = (const bf16_t*)(p.ws + WS_H); g.Bt = (const bf16_t*)(p.ws + WS_WIN) + (size_t)5120 * 1024; g.M = MTOK; g.N = 4096; g.K = 1024;
        EpiT<1> E; E.ws = p.ws; pg8::StaticOrder S; S.init(g.M, g.N, (int)gridDim.x, (int)BIDX());
        pg8::gemm_phase<EpiT<1>, pg8::StaticOrder, false>(lds, g, S, E, nullptr);
      } else if (k == 5) {
        pg8::Gemm g; g.A = (const bf16_t*)(p.ws + WS_H); g.Bt = (const bf16_t*)(p.ws + (size_t)l * SM_LAYER + OFF_WO); g.M = MTOK; g.N = 1024; g.K = 1024;
        EpiT<2> E; E.ws = p.ws; pg8::StaticOrder S; S.init(g.M, g.N, (int)gridDim.x, (int)BIDX());
        pg8::gemm_phase<EpiT<2>, pg8::StaticOrder, false>(lds, g, S, E, nullptr);
      } else if (k == 4) {
        pg8::Gemm g; g.A = (const bf16_t*)(p.ws + WS_ACAT); g.Bt = (const bf16_t*)(p.ws + (size_t)l * SM_LAYER + OFF_WCAT); g.M = MTOK; g.N = 1024; g.K = 1536;
        EpiZ E; E.mg = (const bf16_t*)(p.ws + WS_R + 64 * MiB); E.z = (bf16_t*)(p.ws + WS_H);
        pg8::StaticOrder S; S.init(g.M, g.N, (int)gridDim.x, (int)BIDX());
        pg8::gemm_phase<EpiZ, pg8::StaticOrder, false>(lds, g, S, E, nullptr);
      } else if (k == 1) attn_phase(p, smem);
      else if (k == 3) { lru_pass1(p, l, smem);
        if (l == 0) { __syncthreads(); for (int it = BIDX(); it < 576; it += gridDim.x) convert_win(p, 1, it, (float*)smem); } }
      else { const float* xo = (l == 0) ? p.x : p.out; post_phase(p, l, xo, p.out, l == 0); }
    }
    }
#if TS_K >= 0
    if (blockIdx.x == 0 && threadIdx.x == 0) ((unsigned long long*)(p.ws + WS_BAR + 14336))[32 + ph] = __builtin_amdgcn_s_memrealtime();
#endif
    if (REP_K == 100) GRID_BAR();
    if (ph + 1 < p.ph_hi) GRID_BAR();
  }
#if TS_K >= 0
  GRID_BAR();
  if (blockIdx.x == 0) {
    unsigned long long* ts = (unsigned long long*)(p.ws + WS_BAR + 14336);
    if (threadIdx.x == 0) ts[NPHASE] = __builtin_amdgcn_s_memrealtime();
    __syncthreads();
    float T = 0.f;
    for (int ph = 0; ph < NPHASE; ++ph) { const int kind = ph < 2 ? 100 + ph : (ph - 2) % 7; if (kind == TS_K || TS_K == 500) T += (float)(ts[ph + 1] - ts[ph]) * 0.01f; if (kind + 300 == TS_K) T += (float)(ts[32 + ph] - ts[ph]) * 0.01f; }
    if (TS_K == 999) T = 100.f;
    if (TS_K == 500) T *= 0.1f;
    const float dl = sqrtf(T * 2.5e-6f);
    for (int e = 0; e < 8; ++e) p.out[(size_t)(threadIdx.x * 8 + e) * 1021] += dl;
  }
#endif
}

extern "C" void kernel_launch(void* const* d_in, const int* in_sizes, int n_in, void* d_out, int out_size, void* d_ws, size_t ws_size, hipStream_t stream) {
  static int grid_blocks = 0;
  if (!grid_blocks) {
    (void)hipFuncSetAttribute((const void*)hybrid_fwd, hipFuncAttributeMaxDynamicSharedMemorySize, LDS_BYTES);
    int dev = 0, cus = 0, per_cu = 0;
    (void)hipGetDevice(&dev);
    (void)hipDeviceGetAttribute(&cus, hipDeviceAttributeMultiprocessorCount, dev);
    (void)hipOccupancyMaxActiveBlocksPerMultiprocessor(&per_cu, hybrid_fwd, 512, LDS_BYTES);
    grid_blocks = cus * (per_cu > 0 ? 1 : 0);
    if (grid_blocks > 256) grid_blocks = 256;
  }
  if (ws_size < WS_END || grid_blocks <= 0) { fprintf(stderr, "kernel_launch: workspace %zu < %zu or no resident block\n", ws_size, (size_t)WS_END); return; }
  Params p{};
  p.x = (const float*)d_in[0]; p.c = (const float*)d_in[1]; p.w_mod = (const float*)d_in[2]; p.b_mod = (const float*)d_in[3]; p.g_pre = (const float*)d_in[4];
  p.w_in = (const float*)d_in[5]; p.conv_w = (const float*)d_in[6]; p.conv_b = (const float*)d_in[7]; p.w_rg = (const float*)d_in[8]; p.b_rg = (const float*)d_in[9];
  p.w_ig = (const float*)d_in[10]; p.b_ig = (const float*)d_in[11]; p.lam = (const float*)d_in[12]; p.w_pa = (const float*)d_in[13]; p.w_pb = (const float*)d_in[14];
  p.w_o = (const float*)d_in[15]; p.g_post = (const float*)d_in[16];
  p.out = (float*)d_out; p.ws = (unsigned char*)d_ws; p.ph_lo = 0; p.ph_hi = NPHASE;
  (void)hipMemsetAsync((unsigned char*)d_ws + WS_BAR, 0, 32768, stream);
  void* args[] = {&p};
  hipError_t e = hipLaunchCooperativeKernel((void*)hybrid_fwd, dim3(grid_blocks), dim3(512), args, LDS_BYTES, stream);
  if (e != hipSuccess) fprintf(stderr, "cooperative launch failed: %s (grid %d)\n", hipGetErrorString(e), grid_blocks);
}
```
